# Optimizing an MI355X kernel written in HIP

```python
import numpy as np
import jax
import jax.numpy as jnp
from jax import lax

D_MODEL = 1024
BATCH = 1
SEQ = 16384
DEPTH = 4

GRID_W = 64
CTX_LEN = 256
N_MIXERS = 2
N_HEADS = 16
HEAD_DIM = D_MODEL // N_HEADS
D_FF = 2816
CONV_WIDTH = 31
WIN_R = 8
WIN_C = 16
N_MOD = 9
N_CONV_LAYERS = (DEPTH + 1) // 2
N_NA_LAYERS = DEPTH // 2
RMS_EPS = 1e-6
LN_EPS = 1e-5
MASK_VALUE = -1e30

kernel_name = 'hybrid_conformer_natten_dit_trunk'


def _rmsnorm(x, g):
    xf = x.astype(jnp.float32)
    y = xf * lax.rsqrt(jnp.mean(xf * xf, axis=-1, keepdims=True) + RMS_EPS)
    return y.astype(x.dtype) * g


def _layernorm(x, g, b):
    xf = x.astype(jnp.float32)
    mu = jnp.mean(xf, axis=-1, keepdims=True)
    var = jnp.mean(jnp.square(xf - mu), axis=-1, keepdims=True)
    return ((xf - mu) * lax.rsqrt(var + LN_EPS)).astype(x.dtype) * g + b


def _modulate(h, shift, scale):
    return h * (1 + scale) + shift


def _swiglu(h, wg, wu, wd):
    return (jax.nn.silu(h @ wg) * (h @ wu)) @ wd


def _ffn_half(s, mod, g, wg, wu, wd):
    shift, scale, gate = mod
    h = _modulate(_rmsnorm(s, g), shift, scale)
    return s + 0.5 * gate * _swiglu(h, wg, wu, wd)


def _conv_module(h, w1, b1, wdw, bdw, lng, lnb, w2, b2):
    a, gt = jnp.split(h @ w1 + b1, 2, axis=-1)
    u = a * jax.nn.sigmoid(gt)
    u = lax.conv_general_dilated(
        u, wdw[:, None, :], window_strides=(1,),
        padding=[(CONV_WIDTH // 2, CONV_WIDTH // 2)],
        dimension_numbers=('NWC', 'WIO', 'NWC'),
        feature_group_count=u.shape[-1]) + bdw
    u = jax.nn.silu(_layernorm(u, lng, lnb))
    return u @ w2 + b2


def _col_window_tables():
    ncb = GRID_W // WIN_C
    span = 2 * WIN_C
    n = np.arange(ncb)
    blk_start = np.clip(n * WIN_C - WIN_C // 2, 0, GRID_W - span)
    key_cols = blk_start[:, None] + np.arange(span)[None, :]
    q_cols = n[:, None] * WIN_C + np.arange(WIN_C)[None, :]
    q_start = np.clip(q_cols - WIN_C // 2, 0, GRID_W - WIN_C)
    kc3 = key_cols[:, None, :]
    valid = (kc3 >= q_start[:, :, None]) & (kc3 < q_start[:, :, None] + WIN_C)
    rel = np.clip(kc3 - q_cols[:, :, None], -(WIN_C - 1), WIN_C - 1) + WIN_C - 1
    return key_cols.astype(np.int32), valid, rel.astype(np.int32)


def _neighbourhood_attention(q, k, v, kc, vc, rpb):
    B, T, H, Dh = q.shape
    rows = T // GRID_W
    wr = min(WIN_R, rows)
    key_cols, valid, rel_idx = _col_window_tables()
    ncb, span = key_cols.shape
    key_cols_j = jnp.asarray(key_cols)
    rel_idx_j = jnp.asarray(rel_idx)
    valid_j = jnp.asarray(valid)[None, None, :, :, None, :]
    rpb32 = rpb.astype(jnp.float32)
    qg = (q * (Dh ** -0.5)).reshape(B, rows, ncb, WIN_C, H, Dh).transpose(1, 0, 2, 3, 4, 5)
    kg = k.reshape(B, rows, GRID_W, H, Dh)
    vg = v.reshape(B, rows, GRID_W, H, Dh)

    def row_step(args):
        r, q_row = args
        r0 = jnp.clip(r - wr // 2, 0, rows - wr)
        k_band = lax.dynamic_slice_in_dim(kg, r0, wr, axis=1)
        v_band = lax.dynamic_slice_in_dim(vg, r0, wr, axis=1)
        k_blk = jnp.take(k_band, key_cols_j, axis=2)
        v_blk = jnp.take(v_band, key_cols_j, axis=2)
        s_lat = jnp.einsum('bnqhd,bjnmhd->bhnqjm', q_row, k_blk).astype(jnp.float32)
        rel_r = r0 + jnp.arange(wr) - r + WIN_R - 1
        bias = jnp.take(rpb32, rel_r, axis=1)
        bias = jnp.take(bias, rel_idx_j, axis=2).transpose(0, 2, 3, 1, 4)
        s_lat = jnp.where(valid_j, s_lat + bias, MASK_VALUE)
        s_ctx = jnp.einsum('bnqhd,bkhd->bhnqk', q_row, kc).astype(jnp.float32)
        s = jnp.concatenate([s_lat.reshape(B, H, ncb, WIN_C, wr * span), s_ctx], axis=-1)
        p = jax.nn.softmax(s, axis=-1).astype(v.dtype)
        p_lat = p[..., :wr * span].reshape(B, H, ncb, WIN_C, wr, span)
        p_ctx = p[..., wr * span:]
        return (jnp.einsum('bhnqjm,bjnmhd->bnqhd', p_lat, v_blk)
                + jnp.einsum('bhnqk,bkhd->bnqhd', p_ctx, vc))

    o = lax.map(row_step, (jnp.arange(rows), qg))
    return o.transpose(1, 0, 2, 3, 4, 5).reshape(B, T, H * Dh)


def _context_attention(qc, kc, vc):
    B, K, H, Dh = qc.shape
    s = jnp.einsum('bqhd,bkhd->bhqk', qc * (Dh ** -0.5), kc).astype(jnp.float32)
    p = jax.nn.softmax(s, axis=-1).astype(vc.dtype)
    return jnp.einsum('bhqk,bkhd->bqhd', p, vc).reshape(B, K, H * Dh)


def setup_inputs(seed: int = 0) -> dict:
    key = jax.random.key(seed)
    ks = iter(jax.random.split(key, 32))

    def nrm(shape, scale):
        return jax.random.normal(next(ks), shape, jnp.float32) * scale

    D, F = D_MODEL, D_FF
    return {
        'x': nrm((BATCH, SEQ, D), 1.0),
        'c': nrm((BATCH, D), 1.0),
        'ctx': nrm((BATCH, CTX_LEN, D), 1.0),
        'c_ctx': nrm((D,), 1.0),
        'mod_w': nrm((DEPTH, D, N_MOD * D), 0.5 * D ** -0.5),
        'mod_b': nrm((DEPTH, N_MOD * D), 0.02),
        'norm_g': 1.0 + nrm((DEPTH, 3, D), 0.05),
        'ffn_w_gate': nrm((DEPTH, 2, D, F), D ** -0.5),
        'ffn_w_up': nrm((DEPTH, 2, D, F), D ** -0.5),
        'ffn_w_down': nrm((DEPTH, 2, F, D), F ** -0.5),
        'conv_w_pw1': nrm((N_CONV_LAYERS, D, 2 * D), D ** -0.5),
        'conv_b_pw1': nrm((N_CONV_LAYERS, 2 * D), 0.02),
        'conv_w_dw': nrm((N_CONV_LAYERS, CONV_WIDTH, D), CONV_WIDTH ** -0.5),
        'conv_b_dw': nrm((N_CONV_LAYERS, D), 0.02),
        'conv_ln_g': 1.0 + nrm((N_CONV_LAYERS, D), 0.05),
        'conv_ln_b': nrm((N_CONV_LAYERS, D), 0.02),
        'conv_w_pw2': nrm((N_CONV_LAYERS, D, D), D ** -0.5),
        'conv_b_pw2': nrm((N_CONV_LAYERS, D), 0.02),
        'na_w_qkv': nrm((N_NA_LAYERS, D, 3 * D), D ** -0.5),
        'na_b_qkv': nrm((N_NA_LAYERS, 3 * D), 0.02),
        'na_rpb': nrm((N_NA_LAYERS, N_HEADS, 2 * WIN_R - 1, 2 * WIN_C - 1), 0.1),
        'na_w_o': nrm((N_NA_LAYERS, D, D), D ** -0.5),
        'na_b_o': nrm((N_NA_LAYERS, D), 0.02),
        'final_g': 1.0 + nrm((D,), 0.05),
    }


def reference(x, c, ctx, c_ctx, mod_w, mod_b, norm_g, ffn_w_gate, ffn_w_up, ffn_w_down,
              conv_w_pw1, conv_b_pw1, conv_w_dw, conv_b_dw, conv_ln_g, conv_ln_b, conv_w_pw2, conv_b_pw2,
              na_w_qkv, na_b_qkv, na_rpb, na_w_o, na_b_o, final_g):
    B, T, D = x.shape
    K = ctx.shape[1]
    xc = ctx
    for i in range(DEPTH):
        mixer = i % N_MIXERS
        j = i // N_MIXERS
        last = i == DEPTH - 1
        run_ctx = (not last) or mixer == 1
        ml = (jax.nn.silu(c) @ mod_w[i] + mod_b[i]).reshape(B, 1, N_MOD, D)
        mc = (jax.nn.silu(c_ctx) @ mod_w[i] + mod_b[i]).reshape(N_MOD, D)
        lat_m = [ml[:, :, n] for n in range(N_MOD)]
        ctx_m = [mc[n] for n in range(N_MOD)]

        x = _ffn_half(x, lat_m[0:3], norm_g[i, 0], ffn_w_gate[i, 0], ffn_w_up[i, 0], ffn_w_down[i, 0])
        if run_ctx:
            xc = _ffn_half(xc, ctx_m[0:3], norm_g[i, 0], ffn_w_gate[i, 0], ffn_w_up[i, 0], ffn_w_down[i, 0])

        h = _modulate(_rmsnorm(x, norm_g[i, 1]), lat_m[3], lat_m[4])
        if run_ctx:
            hc = _modulate(_rmsnorm(xc, norm_g[i, 1]), ctx_m[3], ctx_m[4])
        if mixer == 0:
            conv_p = (conv_w_pw1[j], conv_b_pw1[j], conv_w_dw[j], conv_b_dw[j],
                      conv_ln_g[j], conv_ln_b[j], conv_w_pw2[j], conv_b_pw2[j])
            y = _conv_module(h, *conv_p)
            if not last:
                yc = _conv_module(hc, *conv_p)
        else:
            qkv = (h @ na_w_qkv[j] + na_b_qkv[j]).reshape(B, T, 3, N_HEADS, HEAD_DIM)
            qkvc = (hc @ na_w_qkv[j] + na_b_qkv[j]).reshape(B, K, 3, N_HEADS, HEAD_DIM)
            kc, vc = qkvc[:, :, 1], qkvc[:, :, 2]
            o = _neighbourhood_attention(qkv[:, :, 0], qkv[:, :, 1], qkv[:, :, 2], kc, vc, na_rpb[j])
            y = o @ na_w_o[j] + na_b_o[j]
            if not last:
                yc = _context_attention(qkvc[:, :, 0], kc, vc) @ na_w_o[j] + na_b_o[j]
        x = x + lat_m[5] * y

        x = _ffn_half(x, lat_m[6:9], norm_g[i, 2], ffn_w_gate[i, 1], ffn_w_up[i, 1], ffn_w_down[i, 1])
        if not last:
            xc = xc + ctx_m[5] * yc
            xc = _ffn_half(xc, ctx_m[6:9], norm_g[i, 2], ffn_w_gate[i, 1], ffn_w_up[i, 1], ffn_w_down[i, 1])
    return _rmsnorm(x, final_g)
```

```cpp
#include <hip/hip_runtime.h>
#include <hip/hip_cooperative_groups.h>
#include <cstdio>
#include <cstdint>
namespace cg = cooperative_groups;
#ifndef MK_SPLIT
#define MK_SPLIT 0
#endif
namespace pg8 {
#define PG8_LAS __attribute__((address_space(3)))
__device__ __forceinline__ int pg8_tid();
typedef unsigned short bf16_t;
typedef short bf16x8 __attribute__((ext_vector_type(8)));
typedef float f32x4 __attribute__((ext_vector_type(4)));
typedef unsigned u32x4 __attribute__((ext_vector_type(4)));
constexpr int BM = 256, BK = 64, HALF = 128, HTB = HALF * BK * 2  , STAGE_BYTES = 8 * HTB, NXCD = 8, WGM = 8;

__host__ __device__ __forceinline__ int lds_byte(int r, int c) { const int st = (r >> 4) * 2 + (c >> 5), rr = r & 15, cc = c & 31, ob = rr * 64 + cc * 2; return st * 1024 + (ob ^ (((ob >> 9) & 1) << 5)); }
__host__ __device__ __forceinline__ void stage_rc(int b, int& R, int& C) { const int st = b / 1024, sb = b % 1024, swz = sb ^ (((sb >> 9) & 1) << 5); R = (st >> 1) * 16 + swz / 64; C = (st & 1) * 32 + (swz % 64) / 2; }
__host__ __device__ __forceinline__ int perm32(int rho) { const int n = rho >> 4, i = rho & 15; return 8 * (i >> 2) + 4 * n + (i & 3); }

struct Unit { int pm, pn; };
struct Gemm { const bf16_t* A; const bf16_t* Bt; int M, N, K; };

struct StaticOrder {
    int nM, nN, nwg, G, c;
    __host__ __device__ void init(int M, int N, int G_, int c_) { nM = M / BM; nN = N / BM; nwg = nM * nN; G = G_; c = c_; }
    __host__ __device__ bool next(int i, Unit& u) const {
        const long L = (long)i * G + c; if (L >= nwg) return false;
        int wgid = (int)L; { const int q = nwg / NXCD, r = nwg % NXCD, xcd = wgid % NXCD, off = wgid / NXCD; wgid = (xcd < r ? xcd * (q + 1) : r * (q + 1) + (xcd - r) * q) + off; }
        const int nig = WGM * nN, gid = wgid / nig, fm = gid * WGM, gsz = (nM - fm) < WGM ? (nM - fm) : WGM;
        u.pm = fm + ((wgid % nig) % gsz); u.pn = (wgid % nig) / gsz; return true;
    }
    __device__ __forceinline__ void a_ready(const Unit&) const {}
    __device__ __forceinline__ void done(const Unit&) const {}
};

__device__ __forceinline__ unsigned cvt_pk_bf16(float lo, float hi) { unsigned r; asm volatile("v_cvt_pk_bf16_f32 %0, %1, %2" : "=v"(r) : "v"(lo), "v"(hi)); return r; }
typedef float f32x2 __attribute__((ext_vector_type(2)));
typedef float f32x2 __attribute__((ext_vector_type(2)));
typedef float f32x16 __attribute__((ext_vector_type(16)));
constexpr float RMS_EPS_F = 1e-6f;
__device__ __forceinline__ float sigmoid_f(float z) { return __builtin_amdgcn_rcpf(1.f + __builtin_amdgcn_exp2f(-1.44269504f * z)); }

template <int MODE> struct EpiGated {
    static constexpr bool PERM = true, AFTER_DRAIN = false;
    bf16_t* O; int ldc; const float* ssq; const float* cb_lat; const float* cb_ctx;
    __device__ __forceinline__ void operator()(const f32x4 (&acc)[2][2][4][2], const Unit& u, int wr, int wc, int fr, int fq) const {
        const float* cb = (u.pm >= 64) ? cb_ctx : cb_lat;
        const int row0 = u.pm * BM + wr * 64 + fr, bcol0 = u.pn * BM + wc * 32 + 8 * fq, ocol = u.pn * HALF + wc * 32 + 8 * fq;
        constexpr float NL2E = -1.44269504f;
        f32x2 b0[4], b1[4], bz[4];
#pragma unroll
        for (int n = 0; n < 2; ++n) { const f32x4 x0 = *(const f32x4*)(cb + bcol0 + 4 * n), x1 = *(const f32x4*)(cb + bcol0 + HALF + 4 * n);
            b0[2 * n] = (f32x2){x0[0], x0[1]}; b0[2 * n + 1] = (f32x2){x0[2], x0[3]}; b1[2 * n] = (f32x2){x1[0], x1[1]}; b1[2 * n + 1] = (f32x2){x1[2], x1[3]}; }
#pragma unroll
        for (int p = 0; p < 4; ++p) bz[p] = (MODE == 0 ? b0[p] : b1[p]) * NL2E;
        float sq[2][4];
#pragma unroll
        for (int ai = 0; ai < 2; ++ai)
#pragma unroll
            for (int m = 0; m < 4; ++m) sq[ai][m] = ssq[row0 + ai * HALF + m * 16];
#pragma unroll
        for (int ai = 0; ai < 2; ++ai)
#pragma unroll
            for (int m = 0; m < 4; ++m) {
                const int row = row0 + ai * HALF + m * 16;
                const float rs = __builtin_amdgcn_rsqf(sq[ai][m] * (1.0f / 1024.0f) + RMS_EPS_F), rz = rs * NL2E;
                unsigned w[4];
#pragma unroll
                for (int p = 0; p < 4; ++p) {
                    const f32x4 a0 = acc[ai][0][m][p >> 1], a1 = acc[ai][1][m][p >> 1];
                    const f32x2 c0 = (p & 1) ? (f32x2){a0[2], a0[3]} : (f32x2){a0[0], a0[1]}, c1 = (p & 1) ? (f32x2){a1[2], a1[3]} : (f32x2){a1[0], a1[1]};
                    const f32x2 v0 = c0 * rs + b0[p], v1 = c1 * rs + b1[p];
                    const f32x2 t = (MODE == 0 ? c0 : c1) * rz + bz[p];
                    f32x2 d; d.x = __builtin_amdgcn_exp2f(t.x); d.y = __builtin_amdgcn_exp2f(t.y); d = d + 1.0f;
                    f32x2 r; r.x = __builtin_amdgcn_rcpf(d.x); r.y = __builtin_amdgcn_rcpf(d.y);
                    const f32x2 o = (MODE == 0) ? (v0 * v1) * r : v0 * r;
                    w[p] = cvt_pk_bf16(o.x, o.y);
                }
                u32x4 wv; wv.x = w[0]; wv.y = w[1]; wv.z = w[2]; wv.w = w[3];
                *(u32x4*)(O + ((unsigned)row * (unsigned)ldc + (unsigned)ocol)) = wv;
            }
    }
};
struct EpiQKV {
    static constexpr bool PERM = true, AFTER_DRAIN = false;
    bf16_t* O; const float* ssq; const float* cb; float qscale;
    __device__ __forceinline__ void operator()(const f32x4 (&acc)[2][2][4][2], const Unit& u, int wr, int wc, int fr, int fq) const {
        const int row0 = u.pm * BM + wr * 64 + fr, col0 = u.pn * BM + wc * 32 + 8 * fq;
        f32x4 bv[2][2];
#pragma unroll
        for (int bj = 0; bj < 2; ++bj)
#pragma unroll
            for (int n = 0; n < 2; ++n) bv[bj][n] = *(const f32x4*)(cb + col0 + bj * HALF + 4 * n);
        const float sc = (u.pn < 4) ? qscale : 1.f;
        float sq[2][4];
#pragma unroll
        for (int ai = 0; ai < 2; ++ai)
#pragma unroll
            for (int m = 0; m < 4; ++m) sq[ai][m] = ssq[row0 + ai * HALF + m * 16];
#pragma unroll
        for (int ai = 0; ai < 2; ++ai)
#pragma unroll
            for (int m = 0; m < 4; ++m) {
                const int row = row0 + ai * HALF + m * 16;
                const float rs = __builtin_amdgcn_rsqf(sq[ai][m] * (1.0f / 1024.0f) + RMS_EPS_F);
#pragma unroll
                for (int bj = 0; bj < 2; ++bj) {
                    const f32x4 v0 = (acc[ai][bj][m][0] * rs + bv[bj][0]) * sc, v1 = (acc[ai][bj][m][1] * rs + bv[bj][1]) * sc;
                    u32x4 w; w.x = cvt_pk_bf16(v0[0], v0[1]); w.y = cvt_pk_bf16(v0[2], v0[3]); w.z = cvt_pk_bf16(v1[0], v1[1]); w.w = cvt_pk_bf16(v1[2], v1[3]);
                    *(u32x4*)(O + ((unsigned)row * 3072u + (unsigned)(col0 + bj * HALF))) = w;
                }
            }
    }
};
struct EpiResid {
    static constexpr bool PERM = true, AFTER_DRAIN = false;
    const float* xold; float* xnew; bf16_t* xb; float* ssq_out; const float* gate; const float* bias; const float* gn; bool dry;
    __device__ __forceinline__ void operator()(const f32x4 (&acc)[2][2][4][2], const Unit& u, int wr, int wc, int fr, int fq) const {
        const int row0 = u.pm * BM + wr * 64 + fr, col0 = u.pn * BM + wc * 32 + 8 * fq;
        float ss[2][4];
#pragma unroll
        for (int ai = 0; ai < 2; ++ai)
#pragma unroll
            for (int m = 0; m < 4; ++m) ss[ai][m] = 0.f;
#pragma unroll
        for (int bj = 0; bj < 2; ++bj) {
            const int c = col0 + bj * HALF;
            const f32x4 g0 = *(const f32x4*)(gate + c), g1 = *(const f32x4*)(gate + c + 4), n0 = *(const f32x4*)(gn + c), n1 = *(const f32x4*)(gn + c + 4);
            const f32x4 b0 = bias ? *(const f32x4*)(bias + c) : (f32x4){0.f, 0.f, 0.f, 0.f}, b1 = bias ? *(const f32x4*)(bias + c + 4) : (f32x4){0.f, 0.f, 0.f, 0.f};
#pragma unroll
            for (int ai = 0; ai < 2; ++ai) {
                f32x4 xa[4][2];
#pragma unroll
                for (int m = 0; m < 4; ++m) { const unsigned off = (unsigned)(row0 + ai * HALF + m * 16) * 1024u + (unsigned)c; xa[m][0] = *(const f32x4*)(xold + off); xa[m][1] = *(const f32x4*)(xold + off + 4); }
#pragma unroll
                for (int m = 0; m < 4; ++m) {
                    const unsigned off = (unsigned)(row0 + ai * HALF + m * 16) * 1024u + (unsigned)c;
                    const f32x4 x0 = xa[m][0], x1 = xa[m][1];
                    const f32x4 y0 = x0 + g0 * (acc[ai][bj][m][0] + b0), y1 = x1 + g1 * (acc[ai][bj][m][1] + b1);
                    if (!dry) { *(f32x4*)(xnew + off) = y0; *(f32x4*)(xnew + off + 4) = y1; }
                    ss[ai][m] += (y0[0] * y0[0] + y0[1] * y0[1]) + (y0[2] * y0[2] + y0[3] * y0[3]) + (y1[0] * y1[0] + y1[1] * y1[1]) + (y1[2] * y1[2] + y1[3] * y1[3]);
                    asm volatile("" : "+v"(ss[ai][m]));
                    const f32x4 z0 = y0 * n0, z1 = y1 * n1;
                    u32x4 w; w.x = cvt_pk_bf16(z0[0], z0[1]); w.y = cvt_pk_bf16(z0[2], z0[3]); w.z = cvt_pk_bf16(z1[0], z1[1]); w.w = cvt_pk_bf16(z1[2], z1[3]);
                    if (!dry && xb) *(u32x4*)(xb + off) = w;
                }
                asm volatile("" ::: "memory");
            }
        }
#pragma unroll
        for (int ai = 0; ai < 2; ++ai)
#pragma unroll
            for (int m = 0; m < 4; ++m) { float sv = ss[ai][m]; sv += __shfl_xor(sv, 16); sv += __shfl_xor(sv, 32); if (fq == 0 && !dry) atomicAdd(ssq_out + row0 + ai * HALF + m * 16, sv); }
    }
};

struct EpiAny {
    static constexpr bool PERM = true, AFTER_DRAIN = false;
    int kind;
    typedef const __attribute__((address_space(1))) void* gptr;
    gptr p0, p1, p2, p3, p4, p5, p6; int i0; float f0; bool dry;
    __device__ __forceinline__ void operator()(const f32x4 (&acc)[2][2][4][2], const Unit& u, int wr, int wc, int fr, int fq) const {
        gptr q0 = p0, q1 = p1, q2 = p2, q3 = p3;
        if (kind == 0) { asm volatile("" : "+s"(q0), "+s"(q1), "+s"(q2), "+s"(q3)); const EpiGated<0> E{(bf16_t*)q0, i0, (const float*)q1, (const float*)q2, (const float*)q3}; E(acc, u, wr, wc, fr, fq); }
        else if (kind == 1) { asm volatile("" : "+s"(q0), "+s"(q1), "+s"(q2), "+s"(q3)); const EpiGated<1> E{(bf16_t*)q0, i0, (const float*)q1, (const float*)q2, (const float*)q3}; E(acc, u, wr, wc, fr, fq); }
        else if (kind == 2) { asm volatile("" : "+s"(q0), "+s"(q1), "+s"(q2)); const EpiQKV E{(bf16_t*)q0, (const float*)q1, (const float*)q2, f0}; E(acc, u, wr, wc, fr, fq); }
        else { asm volatile("" : "+s"(q0), "+s"(q1), "+s"(q2), "+s"(q3)); const EpiResid E{(const float*)q0, (float*)q1, (bf16_t*)q2, (float*)q3, (const float*)p4, (const float*)p5, (const float*)p6, dry}; E(acc, u, wr, wc, fr, fq); }
    }
};
template <class Epi, class Sched, bool ALIGN_EPI = false, bool SP2 = false>
__device__ __forceinline__ void gemm_phase(PG8_LAS unsigned char* lds, const Gemm g, const Sched& S, const Epi& E) {
    int tid_l = pg8_tid();
    const int tid = tid_l, wid = __builtin_amdgcn_readfirstlane(tid >> 6), lane = tid & 63, wr = wid >> 2, wc = wid & 3, fr = lane & 15, fq = lane >> 4;
    const int K = g.K, nt = K / BK;
    unsigned voffA[2], voffB[2];
#pragma unroll
    for (int i = 0; i < 2; ++i) { int R, C; stage_rc(tid * 16 + i * 8192, R, C); const int Rb = Epi::PERM ? ((R & ~31) + perm32(R & 31)) : R;
        voffA[i] = (unsigned)(R * K + C) * 2u; voffB[i] = (unsigned)(Rb * K + C) * 2u; }
    const size_t kstep = (size_t)(BK * 2);
    const size_t hstep = (size_t)HALF * K * 2;
    const size_t tstep = 2 * hstep;
    const unsigned ldsw = (unsigned)wid * 1024u;
    const int aoff = lds_byte(wr * 64 + fr, fq * 8), boff = lds_byte(wc * 32 + fr, fq * 8);
#define PG8_SA(b, h) (((b) * 2 + (h)) * HTB)
#define PG8_SB(b, h) ((4 + (b) * 2 + (h)) * HTB)
#define PG8_STAGE(bufoff, gbase, voff) do { _Pragma("unroll") for (int _i = 0; _i < 2; ++_i) \
        __builtin_amdgcn_global_load_lds((const unsigned*)((const char*)(gbase) + (voff)[_i]), (PG8_LAS unsigned*)(lds + (bufoff) + ldsw + _i * 8192), 16, 0, 0); } while (0)
#define PG8_LDA(dst, b, h) do { _Pragma("unroll") for (int m = 0; m < 4; ++m) _Pragma("unroll") for (int k = 0; k < 2; ++k) dst[m][k] = *(const PG8_LAS bf16x8*)(lds + PG8_SA(b, h) + aoff + m * 2048 + k * 1024); } while (0)
#define PG8_LDB(dst, b, h) do { _Pragma("unroll") for (int n = 0; n < 2; ++n) _Pragma("unroll") for (int k = 0; k < 2; ++k) dst[n][k] = *(const PG8_LAS bf16x8*)(lds + PG8_SB(b, h) + boff + n * 2048 + k * 1024); } while (0)
#define PG8_MMA(ai, bj, At, Bt) do { __builtin_amdgcn_s_setprio(1); _Pragma("unroll") for (int m = 0; m < 4; ++m) _Pragma("unroll") for (int n = 0; n < 2; ++n) _Pragma("unroll") for (int k = 0; k < 2; ++k) \
        acc[ai][bj][m][n] = __builtin_amdgcn_mfma_f32_16x16x32_bf16(Bt[n][k], At[m][k], acc[ai][bj][m][n], 0, 0, 0); __builtin_amdgcn_s_setprio(0); } while (0)
#define PG8_WAIT_V(n) asm volatile("s_waitcnt vmcnt(" #n ")" ::: "memory")
#define PG8_WAIT_L(n) asm volatile("s_waitcnt lgkmcnt(" #n ")" ::: "memory")
#define PG8_BAR __builtin_amdgcn_s_barrier()
#define PG8_SCHED __builtin_amdgcn_sched_barrier(0)
    Unit cur, nxt; int ui = 0;
    if (!S.next(0, cur)) return;
    f32x4 acc[2][2][4][2];
#pragma unroll
    for (int a = 0; a < 2; ++a)
#pragma unroll
        for (int b = 0; b < 2; ++b)
#pragma unroll
            for (int m = 0; m < 4; ++m)
#pragma unroll
                for (int n = 0; n < 2; ++n) acc[a][b][m][n] = (f32x4){0.f, 0.f, 0.f, 0.f};
    bf16x8 At[4][2], B0[2][2], B1[2][2];
    const char* cA = (const char*)g.A + (size_t)cur.pm * tstep; const char* cB = (const char*)g.Bt + (size_t)cur.pn * tstep;
    S.a_ready(cur);
    if constexpr (SP2) {
        PG8_STAGE(PG8_SB(0, 0), cB, voffB); PG8_STAGE(PG8_SB(0, 1), cB + hstep, voffB); PG8_STAGE(PG8_SA(0, 0), cA, voffA); PG8_STAGE(PG8_SA(0, 1), cA + hstep, voffA);
        if (wr == 1) PG8_BAR;
        PG8_WAIT_V(2); PG8_BAR;
        PG8_STAGE(PG8_SB(1, 0), cB + kstep, voffB); PG8_STAGE(PG8_SA(1, 0), cA + kstep, voffA); PG8_STAGE(PG8_SB(1, 1), cB + hstep + kstep, voffB);
        PG8_WAIT_V(6); PG8_BAR;
    } else {
        PG8_STAGE(PG8_SB(0, 0), cB, voffB); PG8_STAGE(PG8_SA(0, 0), cA, voffA); PG8_STAGE(PG8_SB(0, 1), cB + hstep, voffB); PG8_STAGE(PG8_SA(0, 1), cA + hstep, voffA);
        if (wr == 1) PG8_BAR;
        PG8_WAIT_V(4); PG8_BAR;
        PG8_STAGE(PG8_SB(1, 0), cB + kstep, voffB); PG8_STAGE(PG8_SA(1, 0), cA + kstep, voffA); PG8_STAGE(PG8_SB(1, 1), cB + hstep + kstep, voffB);
        PG8_WAIT_V(6); PG8_BAR;
    }
    for (;;) {
        const bool has_next = S.next(ui + 1, nxt);
        const char* nA = has_next ? (const char*)g.A + (size_t)nxt.pm * tstep : cA; const char* nB = has_next ? (const char*)g.Bt + (size_t)nxt.pn * tstep : cB;
        for (int t = 0; t < nt; t += 2) {
            const bool last = (t == nt - 2);
            const char* a1 = cA + (size_t)(t + 1) * kstep;
            const char* a2 = last ? nA : cA + (size_t)(t + 2) * kstep; const char* b2 = last ? nB : cB + (size_t)(t + 2) * kstep;
            const char* a3 = a2 + kstep; const char* b3 = b2 + kstep;
            if (last && has_next) S.a_ready(nxt);
            if constexpr (SP2) {
            PG8_LDB(B0, 0, 0); PG8_LDB(B1, 0, 1); PG8_SCHED; PG8_LDA(At, 0, 0); PG8_STAGE(PG8_SA(1, 1), a1 + hstep, voffA);
            PG8_WAIT_V(8); PG8_WAIT_L(0); PG8_BAR; PG8_MMA(0, 0, At, B0); PG8_MMA(0, 1, At, B1); PG8_BAR; PG8_SCHED;
            PG8_LDA(At, 0, 1); PG8_STAGE(PG8_SB(0, 0), b2, voffB); PG8_STAGE(PG8_SB(0, 1), b2 + hstep, voffB); PG8_STAGE(PG8_SA(0, 0), a2, voffA);
            PG8_WAIT_V(8); PG8_WAIT_L(0); PG8_BAR; PG8_MMA(1, 0, At, B0); PG8_MMA(1, 1, At, B1); PG8_BAR; PG8_SCHED;
            PG8_LDB(B0, 1, 0); PG8_LDB(B1, 1, 1); PG8_SCHED; PG8_LDA(At, 1, 0); PG8_STAGE(PG8_SA(0, 1), a2 + hstep, voffA);
            PG8_WAIT_V(8); PG8_WAIT_L(0); PG8_BAR; PG8_MMA(0, 0, At, B0); PG8_MMA(0, 1, At, B1); PG8_BAR; PG8_SCHED;
            PG8_LDA(At, 1, 1); PG8_STAGE(PG8_SB(1, 0), b3, voffB); PG8_STAGE(PG8_SB(1, 1), b3 + hstep, voffB); PG8_STAGE(PG8_SA(1, 0), a3, voffA);
            PG8_WAIT_V(8); PG8_WAIT_L(0); PG8_BAR; PG8_MMA(1, 0, At, B0); PG8_MMA(1, 1, At, B1); PG8_BAR; PG8_SCHED;
            } else {
            PG8_LDB(B0, 0, 0); PG8_SCHED; PG8_LDA(At, 0, 0); PG8_STAGE(PG8_SA(1, 1), a1 + hstep, voffA);
            PG8_WAIT_L(8); PG8_BAR; PG8_WAIT_L(0); PG8_MMA(0, 0, At, B0); PG8_BAR; PG8_SCHED;
            PG8_LDB(B1, 0, 1); PG8_STAGE(PG8_SB(0, 0), b2, voffB);
            PG8_BAR; PG8_WAIT_L(0); PG8_MMA(0, 1, At, B1); PG8_BAR;
            PG8_LDA(At, 0, 1); PG8_STAGE(PG8_SA(0, 0), a2, voffA);
            PG8_BAR; PG8_WAIT_L(0); PG8_MMA(1, 0, At, B0); PG8_BAR; PG8_SCHED;
            PG8_STAGE(PG8_SB(0, 1), b2 + hstep, voffB);
            PG8_WAIT_V(6); PG8_BAR; PG8_MMA(1, 1, At, B1); PG8_BAR;
            PG8_LDB(B0, 1, 0); PG8_SCHED; PG8_LDA(At, 1, 0); PG8_STAGE(PG8_SA(0, 1), a2 + hstep, voffA);
            PG8_WAIT_L(8); PG8_BAR; PG8_WAIT_L(0); PG8_MMA(0, 0, At, B0); PG8_BAR; PG8_SCHED;
            PG8_LDB(B1, 1, 1); PG8_STAGE(PG8_SB(1, 0), b3, voffB);
            PG8_BAR; PG8_WAIT_L(0); PG8_MMA(0, 1, At, B1); PG8_BAR;
            PG8_LDA(At, 1, 1); PG8_STAGE(PG8_SA(1, 0), a3, voffA);
            PG8_BAR; PG8_WAIT_L(0); PG8_MMA(1, 0, At, B0); PG8_BAR; PG8_SCHED;
            PG8_STAGE(PG8_SB(1, 1), b3 + hstep, voffB);
            PG8_WAIT_V(6); PG8_BAR; PG8_MMA(1, 1, At, B1); PG8_BAR;
            }
        }
        if constexpr (ALIGN_EPI) { if (wr == 0) PG8_BAR; }
        if constexpr (!Epi::AFTER_DRAIN) { E(acc, cur, wr, wc, fr, fq); S.done(cur); }
        if (!has_next) break;
#pragma unroll
        for (int a = 0; a < 2; ++a)
#pragma unroll
            for (int b = 0; b < 2; ++b)
#pragma unroll
                for (int m = 0; m < 4; ++m)
#pragma unroll
                    for (int n = 0; n < 2; ++n) acc[a][b][m][n] = (f32x4){0.f, 0.f, 0.f, 0.f};
        cur = nxt; cA = nA; cB = nB; ++ui;
        if constexpr (ALIGN_EPI) { if (wr == 1) PG8_BAR; }
    }
    PG8_WAIT_V(0);
    if constexpr (!ALIGN_EPI) { if (wr == 0) PG8_BAR; }
    PG8_BAR;
    if constexpr (Epi::AFTER_DRAIN) { E.fused(acc, cur, wr, wc, fr, fq, lds, wid, lane); S.done(cur); }
#undef PG8_SA
#undef PG8_SB
#undef PG8_STAGE
#undef PG8_LDA
#undef PG8_LDB
#undef PG8_MMA
#undef PG8_WAIT_V
#undef PG8_WAIT_L
#undef PG8_BAR
#undef PG8_SCHED
}
}
using pg8::bf16_t; using pg8::bf16x8; using pg8::f32x4; using pg8::u32x4; using pg8::f32x2; using pg8::f32x16;
#define LAS __attribute__((address_space(3)))
typedef short v4i16_t __attribute__((ext_vector_type(4)));
typedef unsigned u32x2 __attribute__((ext_vector_type(2)));

constexpr int T_LAT = 16384, T_CTX = 256, NR = T_LAT + T_CTX, D = 1024, FF = 2816, NHEAD = 16;
constexpr int NSSQ = 13;
constexpr float LOG2E = 1.44269504f;
constexpr size_t MiB = 1u << 20;
constexpr size_t WS_MODS = 0;
constexpr size_t WS_CB = 1 * MiB;
constexpr size_t WS_GT = 2 * MiB;
constexpr size_t WS_GATE = 2 * MiB + 512 * 1024;
constexpr size_t WS_SSQ = 3 * MiB;
constexpr size_t WS_XC = 4 * MiB;
constexpr size_t WS_BAR = 6 * MiB;
constexpr size_t WS_W = 8 * MiB;
constexpr size_t W_GU = 0, W_D = W_GU + (size_t)8 * 5632 * 1024, W_PW1 = W_D + (size_t)8 * 1024 * 2816, W_PW2 = W_PW1 + (size_t)2 * 2048 * 1024,
                 W_QKV = W_PW2 + (size_t)2 * 1024 * 1024, W_O = W_QKV + (size_t)2 * 3072 * 1024, W_END = W_O + (size_t)2 * 1024 * 1024;
constexpr size_t WS_XB = 170 * MiB;
constexpr size_t WS_H = 203 * MiB;
constexpr size_t WS_QKV = 293 * MiB;
constexpr size_t WS_END = 391 * MiB;
static_assert(WS_W + W_END * 2 <= WS_XB && WS_XB + (size_t)NR * 1024 * 2 <= WS_H && WS_H + (size_t)NR * FF * 2 <= WS_QKV && WS_QKV + (size_t)NR * 3072 * 2 <= WS_END, "ws map");
constexpr int LDS_BYTES = 131072 + 8192;

struct Args { const float* in[24]; float* out; unsigned char* ws; int ph_lo, ph_hi; };

__device__ __forceinline__ float wave_sum(float v) {
#pragma unroll
    for (int o = 1; o < 64; o <<= 1) v += __shfl_xor(v, o);
    return v;
}
extern __shared__ __attribute__((aligned(16))) unsigned char lds_raw[];
constexpr int LDS_TIDTAB = 131072 + 4096 + 64;
__device__ __forceinline__ unsigned hw_wave_key() { return (unsigned)__builtin_amdgcn_s_getreg((5 << 11) | 4) & 63u; }
__device__ __forceinline__ int opaque_tid() {
    const unsigned wv = ((const LAS unsigned*)((LAS unsigned char*)lds_raw + LDS_TIDTAB))[hw_wave_key()];
    unsigned ones = ~0u; asm volatile("" : "+s"(ones));
    int t = (int)(__builtin_amdgcn_readfirstlane(wv) * 64u + __builtin_amdgcn_mbcnt_hi(ones, __builtin_amdgcn_mbcnt_lo(ones, 0u)));
    asm volatile("" : "+v"(t)); return t;
}
__device__ __forceinline__ float bf_lo(unsigned u) { return __uint_as_float(u << 16); }
__device__ __forceinline__ float bf_hi(unsigned u) { return __uint_as_float(u & 0xffff0000u); }
using pg8::cvt_pk_bf16; using pg8::sigmoid_f;
__device__ __forceinline__ int pg8::pg8_tid() { return opaque_tid(); }

#define XB_TMO      128
#define XB_XCNT(j)  (256  + 64 * (j))
#define XB_XSUB(j)  (1280 + 64 * (j))
#define XB_XGEN(j)  (2304 + 64 * (j))
#define XB_TOP      3328
#define XB_TOPGEN   3392
#define XCD_BAR_WORDS 3456
#define XB_SPIN_CAP (1u << 18)

__device__ __forceinline__ unsigned xb_ld(unsigned* p)              { return __hip_atomic_load(p, __ATOMIC_RELAXED, __HIP_MEMORY_SCOPE_AGENT); }
__device__ __forceinline__ unsigned xb_add(unsigned* p, unsigned v) { return __hip_atomic_fetch_add(p, v, __ATOMIC_RELAXED, __HIP_MEMORY_SCOPE_AGENT); }
__device__ __forceinline__ unsigned xb_xcc_id() { return (unsigned)__builtin_amdgcn_s_getreg((3 << 11) | 20) & 0xFu; }
#define XB_SPIN(cond, bar) do { unsigned _sp = 0; while (cond) { __builtin_amdgcn_s_sleep(1); \
    if ((++_sp & 255u) == 0u) { if (xb_ld(&(bar)[XB_TMO])) break; if (_sp > XB_SPIN_CAP) { atomicAdd(&(bar)[XB_TMO], 1u); break; } } } } while (0)

struct XcdBarrier {
    unsigned* bar; unsigned x;
    volatile LAS unsigned* st;
};

__device__ __forceinline__ XcdBarrier xcd_barrier_post(unsigned* bar, volatile LAS unsigned* st) {
    XcdBarrier b; b.bar = bar; b.x = xb_xcc_id(); b.st = st;
    if (threadIdx.x == 0) (void)xb_add(&bar[XB_XCNT(b.x)], 1u);
    return b;
}
__device__ __forceinline__ void xcd_barrier_complete(unsigned* bar, unsigned x, unsigned& nloc, unsigned& nx) {
    const unsigned G = gridDim.x * gridDim.y * gridDim.z;
    unsigned sum, cnt, mine, sp = 0u;
    for (;;) {
        sum = 0u; cnt = 0u; mine = 0u;
#pragma unroll
        for (unsigned j = 0; j < 16; ++j) { const unsigned c = xb_ld(&bar[XB_XCNT(j)]); sum += c; cnt += (c > 0u) ? 1u : 0u; mine = (j == x) ? c : mine; }
        if (sum == G) break;
        __builtin_amdgcn_s_sleep(1);
        if ((++sp & 255u) == 0u) { if (xb_ld(&bar[XB_TMO])) break; if (sp > XB_SPIN_CAP) { atomicAdd(&bar[XB_TMO], 1u); break; } }
    }
    nloc = mine > 0u ? mine : 1u; nx = cnt > 0u ? cnt : 1u;
}

__device__ __forceinline__ void xcd_barrier(const XcdBarrier& b) {
    asm volatile("s_waitcnt vmcnt(0)" ::: "memory");
    __syncthreads();
    if (threadIdx.x == 0) {
        unsigned* bar = b.bar;
        __builtin_amdgcn_s_waitcnt(0);
        unsigned nloc = b.st[0], nx = b.st[1];
        if (nloc == 0u) { xcd_barrier_complete(bar, b.x, nloc, nx); b.st[0] = nloc; b.st[1] = nx; }
        const unsigned old = xb_add(&bar[XB_XSUB(b.x)], 1u);
        const unsigned gen = old / nloc;
        if (old + 1u == (gen + 1u) * nloc) {
            __builtin_amdgcn_fence(__ATOMIC_RELEASE, "agent");
            asm volatile("s_waitcnt vmcnt(0)" ::: "memory");
            const unsigned og = xb_add(&bar[XB_TOP], 1u);
            const unsigned tg = og / nx;
            if (og + 1u == (tg + 1u) * nx) xb_add(&bar[XB_TOPGEN], 1u);
            else XB_SPIN(xb_ld(&bar[XB_TOPGEN]) == tg, bar);
            __builtin_amdgcn_fence(__ATOMIC_ACQUIRE, "agent");
            xb_add(&bar[XB_XGEN(b.x)], 1u);
            asm volatile("s_waitcnt vmcnt(0)" ::: "memory");
        } else {
            XB_SPIN(xb_ld(&bar[XB_XGEN(b.x)]) == gen, bar);
            __builtin_amdgcn_fence(__ATOMIC_ACQUIRE, "agent");
            asm volatile("s_waitcnt vmcnt(0)" ::: "memory");
        }
    }
    __syncthreads();
}

__device__ __forceinline__ void prologue_a(const Args& a, LAS unsigned char* lds, float* MODS, float* CB, float* SSQ) {
    const int tid = opaque_tid(), G = gridDim.x, b = blockIdx.x;
    for (int i = b * 512 + tid; i < NSSQ * NR; i += G * 512) SSQ[i] = 0.f;
    for (int i = b * 512 + tid; i < 4 * 3 * 2 * 5632; i += G * 512) {
        const int n = i % 5632, r = i / 5632, ls = r >> 1, slot = ls % 3, layer = ls / 3;
        float v = 0.f;
        if (slot == 1) { const int j = layer >> 1;
            if ((layer & 1) == 0) { if (n < 2048) { const int pnb = n >> 8, bj = (n >> 7) & 1, jj = n & 127; v = a.in[11][j * 2048 + bj * 1024 + pnb * 128 + jj]; } }
            else { if (n < 3072) v = a.in[19][j * 3072 + n]; } }
        CB[i] = v;
    }
    LAS float* sl = (LAS float*)lds;
    LAS float* red = (LAS float*)(lds + 8192);
    for (int t = tid; t < 2048; t += 512) { const float v = t < 1024 ? a.in[1][t] : a.in[3][t - 1024]; sl[t] = v * sigmoid_f(v); }
    __syncthreads();
    const int w = tid >> 6, lane = tid & 63;
    for (int unit = b; unit < 256; unit += G) {
        const int layer = unit >> 6, c0 = (unit & 63) * 144;
        if (lane < 36) {
            f32x4 al = {0.f, 0.f, 0.f, 0.f}, ac = {0.f, 0.f, 0.f, 0.f};
            const float* wp = a.in[4] + ((size_t)layer * 1024 + w * 128) * 9216 + c0 + 4 * lane;
#pragma unroll 16
            for (int k = 0; k < 128; ++k) { const f32x4 wv = __builtin_nontemporal_load((const f32x4*)(wp + (size_t)k * 9216)); al += wv * sl[w * 128 + k]; ac += wv * sl[1024 + w * 128 + k]; }
            LAS float* r = red + (w * 36 + lane) * 8;
            r[0] = al[0]; r[1] = al[1]; r[2] = al[2]; r[3] = al[3]; r[4] = ac[0]; r[5] = ac[1]; r[6] = ac[2]; r[7] = ac[3];
        }
        __syncthreads();
        if (tid < 288) { const int st = tid / 144, col = tid % 144; float s = 0.f;
#pragma unroll
            for (int w2 = 0; w2 < 8; ++w2) s += red[(w2 * 36 + (col >> 2)) * 8 + st * 4 + (col & 3)];
            s += a.in[5][layer * 9216 + c0 + col];
            MODS[(layer * 2 + st) * 9216 + c0 + col] = s; }
        __syncthreads();
    }
}

struct ConvDesc { const float* src; bf16_t* dst; float* cbl; const float* shl; int K, N, k0, n0, drow; };
__device__ __forceinline__ void convert_load(const ConvDesc& d, int lane, f32x4 (&v)[8], f32x2& sh) {
    const int kr = lane >> 3, c4 = lane & 7;
#pragma unroll
    for (int i = 0; i < 8; ++i) v[i] = __builtin_nontemporal_load((const f32x4*)(d.src + (size_t)(d.k0 + 8 * i + kr) * d.N + d.n0 + 4 * c4));
    sh = (f32x2){0.f, 0.f};
    if (d.cbl) { sh.x = d.shl[d.k0 + lane]; sh.y = d.shl[9216 + d.k0 + lane]; }
}
__device__ __forceinline__ void convert_finish(const ConvDesc& d, const f32x4 (&v)[8], const f32x2& shv, LAS float* scr, int lane, bool nts) {
    const float* src = d.src; (void)src; const int K = d.K, k0 = d.k0, drow = d.drow; bf16_t* dst = d.dst; float* cbl = d.cbl; float* cbc = cbl ? cbl + 5632 : nullptr; const float* shl = d.shl; const float* shc = shl ? shl + 9216 : nullptr;
    { const int kr = lane >> 3, c4 = lane & 7;
#pragma unroll
      for (int i = 0; i < 8; ++i) { LAS float* p = scr + (8 * i + kr) * 33 + 4 * c4; p[0] = v[i][0]; p[1] = v[i][1]; p[2] = v[i][2]; p[3] = v[i][3]; }
      scr[2112 + lane] = shv.x; scr[2176 + lane] = shv.y; }
    asm volatile("s_waitcnt lgkmcnt(0)" ::: "memory");
    const int c = lane & 7;
#pragma unroll
    for (int j = 0; j < 4; ++j) { const int n = (lane >> 3) + 8 * j; const LAS float* s = scr + (8 * c) * 33 + n;
        u32x4 o; o.x = cvt_pk_bf16(s[0 * 33], s[1 * 33]); o.y = cvt_pk_bf16(s[2 * 33], s[3 * 33]); o.z = cvt_pk_bf16(s[4 * 33], s[5 * 33]); o.w = cvt_pk_bf16(s[6 * 33], s[7 * 33]);
        u32x4* dp = (u32x4*)(dst + (size_t)(drow + n) * K + k0 + 8 * c); if (nts) __builtin_nontemporal_store(o, dp); else *dp = o; }
    if (cbl) {
        const int n = lane & 31; const LAS float* sh = scr + ((lane < 32) ? 2112 : 2176); float acc = 0.f; (void)shl; (void)shc;
#pragma unroll 16
        for (int k = 0; k < 64; ++k) acc += scr[k * 33 + n] * sh[k];
        atomicAdd(((lane < 32) ? cbl : cbc) + drow + n, acc);
    }
    asm volatile("s_waitcnt lgkmcnt(0)" ::: "memory");
}
__device__ __forceinline__ int layer_items(int L) { return (L & 1) ? 10496 : 9984; }
__device__ __forceinline__ int layer_item_to_global(int L, int idx) {
    if (idx < 8448) { const int ml = idx / 1408, typ = ml >> 1, s = ml & 1; return (typ * 8 + L * 2 + s) * 1408 + idx % 1408; }
    const int r = idx - 8448, j = L >> 1;
    if ((L & 1) == 0) return r < 1024 ? 33792 + j * 1024 + r : 33792 + 2048 + j * 512 + (r - 1024);
    return r < 1536 ? 33792 + 3072 + j * 1536 + r : 33792 + 6144 + j * 512 + (r - 1536);
}
__device__ __forceinline__ ConvDesc convert_decode(const Args& a, int it, const float* MODS, float* CB, bf16_t* W) {

        const float* src; int K, N, k0, n0, drow; bf16_t* dst; float* cbl = nullptr; const float* shl = nullptr;
        if (it < 33792) {
            const int mtx = it / 1408, r = it % 1408, typ = mtx >> 3, idx = mtx & 7;
            if (typ < 2) { K = 1024; N = FF; k0 = (r / 88) * 64; n0 = (r % 88) * 32; src = a.in[7 + typ] + (size_t)idx * 1024 * FF; dst = W + W_GU + (size_t)idx * 5632 * 1024;
                drow = 256 * (n0 >> 7) + (n0 & 127) + 128 * typ; const int layer = idx >> 1, slot = (idx & 1) * 2;
                cbl = CB + (size_t)((layer * 3 + slot) * 2) * 5632; shl = MODS + (layer * 2) * 9216 + (slot == 0 ? 0 : 6) * 1024; }
            else { K = FF; N = 1024; k0 = (r / 32) * 64; n0 = (r % 32) * 32; src = a.in[9] + (size_t)idx * FF * 1024; dst = W + W_D + (size_t)idx * 1024 * FF; drow = n0; }
        } else {
            int r = it - 33792; K = 1024;
            if (r < 2048) { const int j = r >> 10; r &= 1023; N = 2048; k0 = (r >> 6) * 64; n0 = (r & 63) * 32; src = a.in[10] + (size_t)j * 1024 * 2048; dst = W + W_PW1 + (size_t)j * 2048 * 1024;
                const int n1 = n0 & 1023; drow = 256 * (n1 >> 7) + (n1 & 127) + (n0 >= 1024 ? 128 : 0);
                cbl = CB + (size_t)(((2 * j) * 3 + 1) * 2) * 5632; shl = MODS + ((2 * j) * 2) * 9216 + 3 * 1024; }
            else if (r < 3072) { r -= 2048; const int j = r >> 9; r &= 511; N = 1024; k0 = (r >> 5) * 64; n0 = (r & 31) * 32; src = a.in[16] + (size_t)j * 1024 * 1024; dst = W + W_PW2 + (size_t)j * 1024 * 1024; drow = n0; }
            else if (r < 6144) { r -= 3072; const int j = r / 1536; r %= 1536; N = 3072; k0 = (r / 96) * 64; n0 = (r % 96) * 32; src = a.in[18] + (size_t)j * 1024 * 3072; dst = W + W_QKV + (size_t)j * 3072 * 1024; drow = n0;
                cbl = CB + (size_t)(((2 * j + 1) * 3 + 1) * 2) * 5632; shl = MODS + ((2 * j + 1) * 2) * 9216 + 3 * 1024; }
            else { r -= 6144; const int j = r >> 9; r &= 511; N = 1024; k0 = (r >> 5) * 64; n0 = (r & 31) * 32; src = a.in[21] + (size_t)j * 1024 * 1024; dst = W + W_O + (size_t)j * 1024 * 1024; drow = n0; }
        }
        return ConvDesc{src, dst, cbl, shl, K, N, k0, n0, drow};
    }
__device__ __forceinline__ void convert_layer_range(const Args& a, LAS unsigned char* lds, const float* MODS, float* CB, bf16_t* W, int L, int lo, int hi, int rank, int nwaves, int w, int lane) {
    LAS float* scr = (LAS float*)(lds + w * 16384);
    const bool nts = L > 0;
    int idx = lo + rank; if (idx >= hi) return;
    ConvDesc dA = convert_decode(a, layer_item_to_global(L, idx), MODS, CB, W), dB = dA, dC = dA; f32x4 vA[8], vB[8], vC[8]; f32x2 sA, sB, sC;
    convert_load(dA, lane, vA, sA);
    bool hB = idx + nwaves < hi; if (hB) { dB = convert_decode(a, layer_item_to_global(L, idx + nwaves), MODS, CB, W); convert_load(dB, lane, vB, sB); }
    for (;;) {
        bool hC = hB && (idx + 2 * nwaves < hi); if (hC) { dC = convert_decode(a, layer_item_to_global(L, idx + 2 * nwaves), MODS, CB, W); convert_load(dC, lane, vC, sC); }
        convert_finish(dA, vA, sA, scr, lane, nts); if (!hB) break; idx += nwaves;
        bool hA = hC && (idx + 2 * nwaves < hi); if (hA) { dA = convert_decode(a, layer_item_to_global(L, idx + 2 * nwaves), MODS, CB, W); convert_load(dA, lane, vA, sA); }
        convert_finish(dB, vB, sB, scr, lane, nts); if (!hC) break; idx += nwaves;
        hB = hA && (idx + 2 * nwaves < hi); if (hB) { dB = convert_decode(a, layer_item_to_global(L, idx + 2 * nwaves), MODS, CB, W); convert_load(dB, lane, vB, sB); }
        convert_finish(dC, vC, sC, scr, lane, nts); if (!hA) break; idx += nwaves;
    }
}
__device__ __forceinline__ void prologue_b(const Args& a, LAS unsigned char* lds, const float* MODS, float* CB, float* GT, float* GATE, float* SSQ, bf16_t* W, bf16_t* XB) {
    const int tid = opaque_tid(), G = gridDim.x, b = blockIdx.x, w = __builtin_amdgcn_readfirstlane(tid >> 6), lane = tid & 63;
    for (int i = b * 512 + tid; i < 4 * 3 * 2 * 1024; i += G * 512) {
        const int d = i & 1023, r = i >> 10, st = r & 1, ls = r >> 1, s = ls % 3, layer = ls / 3;
        const float* m = MODS + (layer * 2 + st) * 9216;
        GT[i] = a.in[6][(layer * 3 + s) * 1024 + d] * (1.f + m[(3 * s + 1) * 1024 + d]);
        GATE[i] = (s == 1 ? 1.f : 0.5f) * m[(3 * s + 2) * 1024 + d];
    }
    const int gw = b * 8 + w, NGW = G * 8;
    for (int L = 0; L < 4; ++L) convert_layer_range(a, lds, MODS, CB, W, L, 0, layer_items(L), gw, NGW, w, lane);
    for (int r0 = gw; r0 < NR; r0 += 2 * NGW) {
        f32x4 v[2][4];
#pragma unroll
        for (int q = 0; q < 2; ++q) { const int r = r0 + q * NGW; if (r < NR) { const float* xr = (r >= T_LAT) ? a.in[2] + (size_t)(r - T_LAT) * 1024 : a.in[0] + (size_t)r * 1024;
#pragma unroll
            for (int j = 0; j < 4; ++j) v[q][j] = *(const f32x4*)(xr + 4 * lane + 256 * j); } }
#pragma unroll
        for (int q = 0; q < 2; ++q) { const int r = r0 + q * NGW; if (r < NR) { const int st = r >= T_LAT; const float* m = MODS + st * 9216 + 1024; float s = 0.f;
#pragma unroll
            for (int j = 0; j < 4; ++j) { const int c = 4 * lane + 256 * j; const f32x4 x4 = v[q][j]; s += (x4[0] * x4[0] + x4[1] * x4[1]) + (x4[2] * x4[2] + x4[3] * x4[3]);
                const f32x4 g = *(const f32x4*)(a.in[6] + c) * (*(const f32x4*)(m + c) + 1.f); const f32x4 z = x4 * g;
                u32x2 o; o.x = cvt_pk_bf16(z[0], z[1]); o.y = cvt_pk_bf16(z[2], z[3]); *(u32x2*)(XB + (size_t)r * 1024 + c) = o; }
            s = wave_sum(s); if (lane == 0) SSQ[r] = s; } }
    }
}

template <int NB, int NCH, class Epi>
__device__ __forceinline__ void ctx_gemm(LAS unsigned char* lds, const bf16_t* A, const bf16_t* Bt, int K, int ncb, const Epi& E, int cb0 = 0) {
    const int tid = opaque_tid(), w = __builtin_amdgcn_readfirstlane(tid >> 6), lane = tid & 63, r = lane & 31, hh = lane >> 5;
    constexpr int KW = NCH * 32, BATCH = 6;
    LAS float* red = (LAS float*)lds;
    for (int u = blockIdx.x; u < 8 * ncb; u += gridDim.x) {
        const int rt = u & 7, cb = cb0 + (u >> 3);
        const bf16_t* ap = A + (size_t)(32 * rt + r) * K + w * KW + 16 * hh;
        const bf16_t* bp[NB];
#pragma unroll
        for (int nb = 0; nb < NB; ++nb) bp[nb] = Bt + (size_t)E.brow(32 * cb + r, nb) * K + w * KW + 16 * hh;
        typename Epi::Pre pre[2];
#pragma unroll
        for (int jj = 0; jj < 2; ++jj) { const int reg = (tid >> 6) + 8 * jj; pre[jj] = E.prefetch(32 * rt + (reg & 3) + 8 * (reg >> 2) + 4 * hh, 32 * cb + r); }
        f32x16 acc[NB];
#pragma unroll
        for (int nb = 0; nb < NB; ++nb)
#pragma unroll
            for (int e = 0; e < 16; ++e) acc[nb][e] = 0.f;
#pragma unroll
        for (int c0 = 0; c0 < NCH; c0 += BATCH) {
            bf16x8 af[BATCH][2], bf[NB][BATCH][2];
#pragma unroll
            for (int c = 0; c < BATCH; ++c) if (c0 + c < NCH) {
                af[c][0] = *(const bf16x8*)(ap + (c0 + c) * 32); af[c][1] = *(const bf16x8*)(ap + (c0 + c) * 32 + 8);
#pragma unroll
                for (int nb = 0; nb < NB; ++nb) { bf[nb][c][0] = *(const bf16x8*)(bp[nb] + (c0 + c) * 32); bf[nb][c][1] = *(const bf16x8*)(bp[nb] + (c0 + c) * 32 + 8); }
            }
#pragma unroll
            for (int c = 0; c < BATCH; ++c) if (c0 + c < NCH) {
#pragma unroll
                for (int nb = 0; nb < NB; ++nb) { acc[nb] = __builtin_amdgcn_mfma_f32_32x32x16_bf16(af[c][0], bf[nb][c][0], acc[nb], 0, 0, 0); acc[nb] = __builtin_amdgcn_mfma_f32_32x32x16_bf16(af[c][1], bf[nb][c][1], acc[nb], 0, 0, 0); }
            }
        }
#pragma unroll
        for (int nb = 0; nb < NB; ++nb)
#pragma unroll
            for (int e = 0; e < 16; ++e) red[((w * NB + nb) * 16 + e) * 64 + lane] = acc[nb][e];
        __syncthreads();
#pragma unroll
        for (int jj = 0; jj < 2; ++jj) {
            const int reg = (tid >> 6) + 8 * jj; float v[NB];
#pragma unroll
            for (int nb = 0; nb < NB; ++nb) { float s = 0.f;
#pragma unroll
                for (int w2 = 0; w2 < 8; ++w2) s += red[((w2 * NB + nb) * 16 + reg) * 64 + lane];
                v[nb] = s; }
            const int row = (reg & 3) + 8 * (reg >> 2) + 4 * hh, col = r;
            E.apply(pre[jj], 32 * rt + row, 32 * cb + col, v[0], NB > 1 ? v[NB - 1] : 0.f);
        }
        __syncthreads();
    }
}
struct CtxGlu {
    bf16_t* O; const float* ssq; const float* cb;
    struct Pre { float ss, c0, c1; };
    __device__ __forceinline__ int brow(int c, int nb) const { return 256 * (c >> 7) + (c & 127) + 128 * nb; }
    __device__ __forceinline__ Pre prefetch(int row, int col) const { const int c = 256 * (col >> 7) + (col & 127); return Pre{ssq[T_LAT + row], cb[c], cb[c + 128]}; }
    __device__ __forceinline__ void apply(const Pre& p, int row, int col, float v0, float v1) const {
        const float rs = __builtin_amdgcn_rsqf(p.ss * (1.0f / 1024.0f) + pg8::RMS_EPS_F);
        const float a0 = v0 * rs + p.c0, g0 = v1 * rs + p.c1;
        O[(size_t)(T_LAT + row) * 1024 + col] = (bf16_t)(cvt_pk_bf16(a0 * sigmoid_f(g0), 0.f) & 0xffffu);
    }
};
struct CtxQkv {
    bf16_t* O; const float* ssq; const float* cb; float qscale;
    struct Pre { float ss, c0; };
    __device__ __forceinline__ int brow(int c, int) const { return c; }
    __device__ __forceinline__ Pre prefetch(int row, int col) const { return Pre{ssq[T_LAT + row], cb[col]}; }
    __device__ __forceinline__ void apply(const Pre& p, int row, int col, float v0, float) const {
        const float rs = __builtin_amdgcn_rsqf(p.ss * (1.0f / 1024.0f) + pg8::RMS_EPS_F);
        const float v = (v0 * rs + p.c0) * (col < 1024 ? qscale : 1.f);
        O[(size_t)(T_LAT + row) * 3072 + col] = (bf16_t)(cvt_pk_bf16(v, 0.f) & 0xffffu);
    }
};
struct CtxResid {
    const float* xold; float* xnew; bf16_t* xb; float* ssq_out; const float* gate; const float* bias; const float* gn; bool dry;
    struct Pre { float x, g, b, n; };
    __device__ __forceinline__ int brow(int c, int) const { return c; }
    __device__ __forceinline__ Pre prefetch(int row, int col) const { return Pre{xold[(size_t)row * 1024 + col], gate[col], bias ? bias[col] : 0.f, gn[col]}; }
    __device__ __forceinline__ void apply(const Pre& p, int row, int col, float v0, float) const {
        const float y = p.x + p.g * (v0 + p.b);
        if (!dry) { xnew[(size_t)row * 1024 + col] = y; xb[(size_t)(T_LAT + row) * 1024 + col] = (bf16_t)(cvt_pk_bf16(y * p.n, 0.f) & 0xffffu); }
        float s = y * y;
        s += __shfl_xor(s, 1); s += __shfl_xor(s, 2); s += __shfl_xor(s, 4); s += __shfl_xor(s, 8); s += __shfl_xor(s, 16);
        if ((col & 31) == 0 && !dry) atomicAdd(ssq_out + T_LAT + row, s);
    }
};

__device__ __forceinline__ void conv_ln_token(const LAS float* cvrow, const float* lng, const float* lnb, bf16_t* vrow, int lane) {
    f32x4 v[4]; float s = 0.f;
#pragma unroll
    for (int jj = 0; jj < 4; ++jj) { v[jj] = *(const LAS f32x4*)(cvrow + 4 * lane + 256 * jj); s += (v[jj][0] + v[jj][1]) + (v[jj][2] + v[jj][3]); }
    const float mean = wave_sum(s) * (1.0f / 1024.0f); float s2 = 0.f;
#pragma unroll
    for (int jj = 0; jj < 4; ++jj) { v[jj] = v[jj] - mean; s2 += (v[jj][0] * v[jj][0] + v[jj][1] * v[jj][1]) + (v[jj][2] * v[jj][2] + v[jj][3] * v[jj][3]); }
    const float rstd = __builtin_amdgcn_rsqf(wave_sum(s2) * (1.0f / 1024.0f) + 1e-5f);
#pragma unroll
    for (int jj = 0; jj < 4; ++jj) { const int c = 4 * lane + 256 * jj; const f32x4 y = v[jj] * rstd * *(const f32x4*)(lng + c) + *(const f32x4*)(lnb + c);
        u32x2 o; o.x = cvt_pk_bf16(y[0] * sigmoid_f(y[0]), y[1] * sigmoid_f(y[1])); o.y = cvt_pk_bf16(y[2] * sigmoid_f(y[2]), y[3] * sigmoid_f(y[3]));
        *(u32x2*)(vrow + c) = o; }
}
__device__ __forceinline__ void conv_mid(const Args& a, LAS unsigned char* lds, int j, const bf16_t* U, bf16_t* V) {
    const int tid = opaque_tid(), w = tid >> 6, lane = tid & 63, ch = 2 * tid;
    const float* wdw = a.in[12] + (size_t)j * 31 * 1024; const float* bdw = a.in[13] + j * 1024; const float* lng = a.in[14] + j * 1024; const float* lnb = a.in[15] + j * 1024;
    f32x2 wv[31];
#pragma unroll
    for (int i = 0; i < 31; ++i) wv[i] = *(const f32x2*)(wdw + i * 1024 + ch);
    const f32x2 bd = *(const f32x2*)(bdw + ch);
    LAS float* cv = (LAS float*)lds;
    for (int ct = blockIdx.x; ct < T_CTX; ct += gridDim.x) {
        unsigned raw[31];
#pragma unroll
        for (int r = 0; r < 31; ++r) { const int t = min(max(ct - 15 + r, 0), T_CTX - 1); raw[r] = *(const unsigned*)(U + (size_t)(T_LAT + t) * 1024 + ch); }
        f32x2 acc = bd;
#pragma unroll
        for (int r = 0; r < 31; ++r) { const int t = ct - 15 + r; const bool ok = (t >= 0) && (t < T_CTX); f32x2 u; u.x = ok ? bf_lo(raw[r]) : 0.f; u.y = ok ? bf_hi(raw[r]) : 0.f; acc += u * wv[r]; }
        *(LAS f32x2*)(cv + ch) = acc;
        __syncthreads();
        if (w == 0) conv_ln_token(cv, lng, lnb, V + (size_t)(T_LAT + ct) * 1024, lane);
        __syncthreads();
    }
    constexpr int TPI = 8, WIN = 30 + TPI, NIT = 64 / TPI;
    for (int c64 = blockIdx.x; c64 < T_LAT / 64; c64 += gridDim.x) {
        const int t0 = 64 * c64; const bf16_t* up = U + ch;
        f32x2 u[WIN];
        { unsigned raw[WIN];
#pragma unroll
          for (int i = 0; i < WIN; ++i) { const int t = min(max(t0 - 15 + i, 0), T_LAT - 1); raw[i] = *(const unsigned*)(up + (size_t)t * 1024); }
#pragma unroll
          for (int i = 0; i < WIN; ++i) { const int t = t0 - 15 + i; const bool ok = (t >= 0) && (t < T_LAT); u[i].x = ok ? bf_lo(raw[i]) : 0.f; u[i].y = ok ? bf_hi(raw[i]) : 0.f; } }
        unsigned nrA[TPI];
#pragma unroll
        for (int k = 0; k < TPI; ++k) { const int t = min(t0 + WIN - 15 + k, T_LAT - 1); nrA[k] = *(const unsigned*)(up + (size_t)t * 1024); }
#pragma unroll 1
        for (int it = 0; it < NIT; ++it) {
            unsigned nrB[TPI];
#pragma unroll
            for (int k = 0; k < TPI; ++k) { const int t = min(t0 + TPI * it + WIN - 15 + TPI + k, T_LAT - 1); nrB[k] = *(const unsigned*)(up + (size_t)t * 1024); }
            f32x2 o[TPI];
#pragma unroll
            for (int k = 0; k < TPI; ++k) o[k] = bd;
#pragma unroll
            for (int jj = 0; jj < 31; ++jj)
#pragma unroll
                for (int k = 0; k < TPI; ++k) o[k] += u[k + jj] * wv[jj];
#pragma unroll
            for (int k = 0; k < TPI; ++k) *(LAS f32x2*)(cv + ((TPI * it + k) & 31) * 1024 + ch) = o[k];
#pragma unroll
            for (int i = 0; i < 30; ++i) u[i] = u[i + TPI];
#pragma unroll
            for (int k = 0; k < TPI; ++k) { const bool ok = (t0 + TPI * it + WIN - 15 + k) < T_LAT; u[30 + k].x = ok ? bf_lo(nrA[k]) : 0.f; u[30 + k].y = ok ? bf_hi(nrA[k]) : 0.f; nrA[k] = nrB[k]; }
            if ((it & (32 / TPI - 1)) == 32 / TPI - 1) {
                __syncthreads();
#pragma unroll 1
                for (int q = 0; q < 4; ++q) { const int tt = 4 * w + q; conv_ln_token(cv + tt * 1024, lng, lnb, V + (size_t)(t0 + 32 * (it / (32 / TPI)) + tt) * 1024, lane); }
                __syncthreads();
            }
        }
    }
}

__device__ __forceinline__ void attn_softmax_pv(f32x16& S, const u32x4 (&vc)[4], int t, const LAS float* tb, LAS unsigned char* vbuf, unsigned vst_off, unsigned vrd_off,
                                                int r0a, int r0q, int qrow, int bidx0, unsigned cm, f32x16& o0, f32x16& o1, float& m, float& l) {
    if (t >= 8) { const int jr = r0a + t - 8; const unsigned vm = ((jr >= r0q) & (jr < r0q + 8)) ? cm : 0u; const LAS float* tr = tb + (jr - qrow + 7) * 64 + bidx0;
        float bz[16];
#pragma unroll
        for (int reg = 0; reg < 16; ++reg) { bz[reg] = tr[(reg & 3) + 8 * (reg >> 2)]; }
#pragma unroll
        for (int reg = 0; reg < 16; ++reg) { asm volatile("" : "+v"(bz[reg])); }
#pragma unroll
        for (int reg = 0; reg < 16; ++reg) { const float sb = S[reg] + bz[reg];
            const unsigned keep = (unsigned)__builtin_amdgcn_sbfe((int)vm, reg, 1);
            S[reg] = __uint_as_float((__float_as_uint(sb) & keep) | (0xf149f2cau & ~keep)); } }
    float mx = S[0];
#pragma unroll
    for (int e = 1; e < 16; ++e) mx = fmaxf(mx, S[e]);
    mx = fmaxf(mx, __shfl_xor(mx, 32));
    if (__builtin_amdgcn_ballot_w64(mx > m + 8.0f) != 0ull) {
        const float mnew = fmaxf(m, mx), alpha = __builtin_amdgcn_exp2f(m - mnew); m = mnew; l *= alpha;
#pragma unroll
        for (int e = 0; e < 16; ++e) { o0[e] *= alpha; o1[e] *= alpha; }
    }
    float ps = 0.f;
#pragma unroll
    for (int e = 0; e < 16; ++e) { S[e] = __builtin_amdgcn_exp2f(S[e] - m); ps += S[e]; }
    l += ps;
    bf16x8 pf[2];
#pragma unroll
    for (int s2 = 0; s2 < 2; ++s2) { u32x4 pw; pw.x = cvt_pk_bf16(S[8 * s2 + 0], S[8 * s2 + 1]); pw.y = cvt_pk_bf16(S[8 * s2 + 2], S[8 * s2 + 3]); pw.z = cvt_pk_bf16(S[8 * s2 + 4], S[8 * s2 + 5]); pw.w = cvt_pk_bf16(S[8 * s2 + 6], S[8 * s2 + 7]);
        pf[s2] = __builtin_bit_cast(bf16x8, pw); }
#pragma unroll
    for (int i = 0; i < 4; ++i) *(LAS u32x4*)(vbuf + vst_off + i * 512) = vc[i];
#pragma unroll
    for (int s2 = 0; s2 < 2; ++s2) {
#pragma unroll
        for (int dt = 0; dt < 2; ++dt) {
            const v4i16_t lo = __builtin_amdgcn_ds_read_tr16_b64_v4i16((LAS v4i16_t*)(vbuf + vrd_off + dt * 2048 + s2 * 1024));
            const v4i16_t hi = __builtin_amdgcn_ds_read_tr16_b64_v4i16((LAS v4i16_t*)(vbuf + vrd_off + dt * 2048 + s2 * 1024 + 512));
            bf16x8 vf; vf[0] = lo[0]; vf[1] = lo[1]; vf[2] = lo[2]; vf[3] = lo[3]; vf[4] = hi[0]; vf[5] = hi[1]; vf[6] = hi[2]; vf[7] = hi[3];
            if (dt == 0) o0 = __builtin_amdgcn_mfma_f32_32x32x16_bf16(vf, pf[s2], o0, 0, 0, 0); else o1 = __builtin_amdgcn_mfma_f32_32x32x16_bf16(vf, pf[s2], o1, 0, 0, 0);
        }
    }
}
__device__ __forceinline__ void attn_unit(const bf16_t* __restrict__ QKV, bf16_t* __restrict__ O, const LAS float* tb, LAS unsigned char* vbuf, int h, bool ctxq, int rp, int n, int lane) {
    const int ql = lane & 31, hh = lane >> 5;
    int qrow = 0, qcol = 0, qtok, cs = 0, r0a = 0, nlat = 0, r0q = 0, ws = 0;
    if (ctxq) { qtok = T_LAT + 32 * rp + ql; }
    else { qrow = 2 * rp + (ql >> 4); qcol = 16 * n + (ql & 15); qtok = qrow * 64 + qcol; cs = min(max(16 * n - 8, 0), 32); ws = min(max(qcol - 8, 0), 48);
        r0a = min(max(2 * rp - 4, 0), 248); const int r0b = min(max(2 * rp - 3, 0), 248); nlat = r0b - r0a + 8; r0q = (ql >> 4) ? r0b : r0a; }
    const int ntiles = 8 + nlat;
    bf16x8 qf[4];
    { const bf16_t* qp = QKV + (size_t)qtok * 3072 + h * 64 + 8 * hh;
#pragma unroll
      for (int s = 0; s < 4; ++s) qf[s] = *(const bf16x8*)(qp + 16 * s); }
    unsigned cm = 0;
#pragma unroll
    for (int reg = 0; reg < 16; ++reg) { const int kreg = (reg & 3) + 8 * (reg >> 2); cm |= ((unsigned)(cs + 4 * hh + kreg - ws) < 16u ? 1u : 0u) << reg; }
    const int bidx0 = cs + 4 * hh - qcol + 32;
    const int skey = lane >> 3, sch = lane & 7;
    const unsigned vst_off = (unsigned)((sch >> 2) * 2048 + (sch & 3) * 16 + skey * 64);
    const unsigned vrd_off = (unsigned)(((lane >> 4) & 1) * 32 + (lane & 3) * 8 + (4 * hh + ((lane & 15) >> 2)) * 64);
    const bf16_t* kbase = QKV + 1024 + h * 64 + 8 * hh + (size_t)ql * 3072;
    const bf16_t* vbase = QKV + 2048 + h * 64 + 8 * sch + (size_t)skey * 3072;
    f32x16 o0, o1;
#pragma unroll
    for (int e = 0; e < 16; ++e) { o0[e] = 0.f; o1[e] = 0.f; }
    float m = -1e30f, l = 0.f;
    bf16x8 kA[4], kB[4]; u32x4 vA[4], vB[4]; f32x16 SA, SB;
#define ATT_TOKBASE(t) ((t) < 8 ? T_LAT + 32 * (t) : (r0a + (t) - 8) * 64 + cs)
#define ATT_LOADK(dst, tile) do { const size_t tbs_ = (size_t)ATT_TOKBASE(tile) * 3072; _Pragma("unroll") for (int s = 0; s < 4; ++s) dst[s] = *(const bf16x8*)(kbase + tbs_ + 16 * s); } while (0)
#define ATT_LOADV(dst, tile) do { const size_t tbs_ = (size_t)ATT_TOKBASE(tile) * 3072; _Pragma("unroll") for (int s = 0; s < 4; ++s) dst[s] = *(const u32x4*)(vbase + tbs_ + (size_t)(8 * s) * 3072); } while (0)
#define ATT_QK(S, K) do { _Pragma("unroll") for (int e = 0; e < 16; ++e) S[e] = 0.f; _Pragma("unroll") for (int s = 0; s < 4; ++s) S = __builtin_amdgcn_mfma_f32_32x32x16_bf16(K[s], qf[s], S, 0, 0, 0); } while (0)
#define ATT_STEP(t, Scur, Snext, Kfree, Knext, Vcur, Vnext) do { \
        { const int t2_ = min((t) + 2, ntiles - 1); ATT_LOADK(Kfree, t2_); } { const int t1_ = min((t) + 1, ntiles - 1); ATT_LOADV(Vnext, t1_); } \
        ATT_QK(Snext, Knext); \
        attn_softmax_pv(Scur, Vcur, (t), tb, vbuf, vst_off, vrd_off, r0a, r0q, qrow, bidx0, cm, o0, o1, m, l); } while (0)
    ATT_LOADK(kA, 0); ATT_LOADV(vA, 0); ATT_LOADK(kB, 1);
    ATT_QK(SA, kA);
    int t = 0;
#pragma unroll 1
    for (; t + 1 < ntiles; t += 2) { ATT_STEP(t, SA, SB, kA, kB, vA, vB); ATT_STEP(t + 1, SB, SA, kB, kA, vB, vA); }
    if (t < ntiles) ATT_STEP(t, SA, SB, kA, kB, vA, vB);
#undef ATT_STEP
#undef ATT_QK
#undef ATT_LOADV
#undef ATT_LOADK
#undef ATT_TOKBASE
    l += __shfl_xor(l, 32);
    const float inv = 1.0f / l;
    bf16_t* op = O + (size_t)qtok * 1024 + h * 64 + 4 * hh;
#pragma unroll
    for (int rg = 0; rg < 4; ++rg) {
        u32x2 a0; a0.x = cvt_pk_bf16(o0[4 * rg] * inv, o0[4 * rg + 1] * inv); a0.y = cvt_pk_bf16(o0[4 * rg + 2] * inv, o0[4 * rg + 3] * inv); *(u32x2*)(op + 8 * rg) = a0;
        u32x2 a1; a1.x = cvt_pk_bf16(o1[4 * rg] * inv, o1[4 * rg + 1] * inv); a1.y = cvt_pk_bf16(o1[4 * rg + 2] * inv, o1[4 * rg + 3] * inv); *(u32x2*)(op + 32 + 8 * rg) = a1;
    }
}
__device__ __forceinline__ void attn_mid(const Args& a, LAS unsigned char* lds, int j, bool ctx_q, const bf16_t* QKV, bf16_t* O) {
    const int tid = opaque_tid(), w = __builtin_amdgcn_readfirstlane(tid >> 6), lane = tid & 63;
    LAS float* tb = (LAS float*)lds;
    LAS unsigned char* vbuf = lds + 4096 + w * 4096;
    for (int wu = blockIdx.x; wu < 256; wu += gridDim.x) {
        const int h = wu & 15, g = wu >> 4;
        __syncthreads();
        for (int e = tid; e < 1024; e += 512) { const int dr = e >> 6, dc = (e & 63) - 32; float v = 0.f;
            if (dr < 15 && dc >= -15 && dc <= 15) v = a.in[20][((size_t)(j * NHEAD + h) * 15 + dr) * 31 + dc + 15] * LOG2E;
            tb[e] = v; }
        __syncthreads();
        const int nun = (ctx_q && wu < 128 && w == 0) ? 5 : 4;
        for (int i = 0; i < nun; ++i) { const bool cq = (i == 4); const int tl = g * 32 + w * 4 + i; attn_unit(QKV, O, tb, vbuf, h, cq, cq ? (wu >> 4) : (tl >> 2), tl & 3, lane); }
    }
}
constexpr int N_PHASES = 31;
__device__ __forceinline__ const Args* args_ptr() {
    auto p = __builtin_amdgcn_kernarg_segment_ptr(); asm volatile("" : "+s"(p)); return (const Args*)p;
}
#define WS_PTRS(a) unsigned char* ws = (a).ws; float* MODS = (float*)(ws + WS_MODS); float* CB = (float*)(ws + WS_CB); float* GT = (float*)(ws + WS_GT); float* GATE = (float*)(ws + WS_GATE); \
    float* SSQ = (float*)(ws + WS_SSQ); float* XC = (float*)(ws + WS_XC); bf16_t* W = (bf16_t*)(ws + WS_W); bf16_t* XB = (bf16_t*)(ws + WS_XB); bf16_t* H = (bf16_t*)(ws + WS_H); bf16_t* OB = (bf16_t*)(ws + WS_H); \
    bf16_t* QKV = (bf16_t*)(ws + WS_QKV); bf16_t* UB = QKV; bf16_t* VB = QKV + (size_t)NR * 1024; float* X = (a).out; \
    (void)MODS; (void)CB; (void)GT; (void)GATE; (void)SSQ; (void)XC; (void)W; (void)XB; (void)H; (void)OB; (void)QKV; (void)UB; (void)VB; (void)X
__global__ void __launch_bounds__(512, 2) fwd_megakernel(Args a_) {
    LAS unsigned char* lds = (LAS unsigned char*)lds_raw;
    if ((threadIdx.x & 63) == 0) ((LAS unsigned*)(lds + LDS_TIDTAB))[hw_wave_key()] = threadIdx.x >> 6;
    const int lo = a_.ph_lo, hi = a_.ph_hi;
#define IN(k) (lo <= (k) && (k) < hi)
#if MK_SPLIT
#define SEAM(k) do { } while (0)
#else
#ifdef PROBE_BAR2
#define SEAM(k) do { if (IN(k) && IN((k) + 1)) { xcd_barrier(bar); xcd_barrier(bar); } } while (0)
#else
#define SEAM(k) do { if (IN(k) && IN((k) + 1)) xcd_barrier(bar); } while (0)
#endif
#endif
    unsigned* barw = (unsigned*)(a_.ws + WS_BAR);
    volatile LAS unsigned* bst = (volatile LAS unsigned*)(lds + 131072 + 4096);
    if (threadIdx.x < 2) bst[threadIdx.x] = 0u;
    __syncthreads();
    #ifndef DIS_PA
    if (IN(0)) { const Args& a = *args_ptr(); WS_PTRS(a); prologue_a(a, lds, MODS, CB, SSQ); }
#endif
#if MK_SPLIT
    XcdBarrier bar; bar.bar = barw; bar.x = 0; bar.st = bst;
#else
    if (lo < 0) cg::this_grid().sync();
    XcdBarrier bar = xcd_barrier_post(barw, bst);
#endif
    SEAM(0);
#ifndef DIS_PB
    if (IN(1)) { const Args& a = *args_ptr(); WS_PTRS(a); prologue_b(a, lds, MODS, CB, GT, GATE, SSQ, W, XB); }
#endif
    SEAM(1);
#ifdef DUPMASK
    bool dup_second = false;
#endif
    for (int st = 0; st < 28; ++st) {
        if (IN(2 + st)) {
            const Args& a = *args_ptr(); WS_PTRS(a);
            int st_o = st; asm volatile("" : "+s"(st_o));
            const int layer = st_o / 7, k = st_o % 7, j = layer >> 1; const bool conv = (layer & 1) == 0, last = layer == 3;
#ifdef DUPMASK
            const bool dup_this = (((DUPMASK) >> k) & 1) && (((DUPLAYERS) >> layer) & 1);
            const bool dry = dup_this && !dup_second;
#else
            const bool dry = false;
#endif
            if (k != 3) {
                pg8::Gemm g; pg8::EpiAny E{}; E.dry = dry;
                const float* gate_l = nullptr; const float* gn_l = nullptr; float* ssq_out = nullptr; const float* bias = nullptr; bool first = false;
                if (k == 0 || k == 5) { const int s = (k == 0) ? 0 : 1, slot = 2 * s;
                    g = pg8::Gemm{XB, W + W_GU + (size_t)(layer * 2 + s) * 5632 * 1024, (k == 5 && last) ? T_LAT : NR, 5632, 1024};
                    E.kind = 0; E.p0 = (pg8::EpiAny::gptr)(H); E.i0 = FF; E.p1 = (pg8::EpiAny::gptr)(SSQ + (size_t)(3 * layer + slot) * NR); E.p2 = (pg8::EpiAny::gptr)(CB + (size_t)((layer * 3 + slot) * 2) * 5632); E.p3 = (pg8::EpiAny::gptr)(CB + (size_t)((layer * 3 + slot) * 2 + 1) * 5632); }
                else if (k == 2 && conv) { g = pg8::Gemm{XB, W + W_PW1 + (size_t)j * 2048 * 1024, T_LAT, 2048, 1024};
                    E.kind = 1; E.p0 = (pg8::EpiAny::gptr)(UB); E.i0 = 1024; E.p1 = (pg8::EpiAny::gptr)(SSQ + (size_t)(3 * layer + 1) * NR); E.p2 = (pg8::EpiAny::gptr)(CB + (size_t)((layer * 3 + 1) * 2) * 5632); E.p3 = (pg8::EpiAny::gptr)(CB + (size_t)((layer * 3 + 1) * 2 + 1) * 5632); }
                else if (k == 2) { g = pg8::Gemm{XB, W + W_QKV + (size_t)j * 3072 * 1024, T_LAT, 3072, 1024};
                    E.kind = 2; E.p0 = (pg8::EpiAny::gptr)(QKV); E.p1 = (pg8::EpiAny::gptr)(SSQ + (size_t)(3 * layer + 1) * NR); E.p2 = (pg8::EpiAny::gptr)(CB + (size_t)((layer * 3 + 1) * 2) * 5632); E.f0 = 0.125f * LOG2E; }
                else { const int s = (k == 1) ? 0 : (k == 4 ? 1 : 2);
                    const bf16_t* A; const bf16_t* Bt; int K;
                    if (k == 4) { K = 1024; if (conv) { A = VB; Bt = W + W_PW2 + (size_t)j * 1024 * 1024; bias = a.in[17] + j * 1024; } else { A = OB; Bt = W + W_O + (size_t)j * 1024 * 1024; bias = a.in[22] + j * 1024; } }
                    else { K = FF; A = H; Bt = W + W_D + (size_t)(layer * 2 + (k == 6 ? 1 : 0)) * 1024 * FF; }
                    const int ns = (s == 2) ? (last ? (3 * 3 + 2) : ((layer + 1) * 3)) : (layer * 3 + s + 1);
                    gate_l = GATE + (size_t)((layer * 3 + s) * 2) * 1024; gn_l = GT + (size_t)(ns * 2) * 1024;
                    ssq_out = SSQ + (size_t)(3 * layer + s + 1) * NR; first = (layer == 0 && k == 1);
                    g = pg8::Gemm{A, Bt, T_LAT, 1024, K};
                    E.kind = 3; E.p0 = (pg8::EpiAny::gptr)(first ? a.in[0] : X); E.p1 = (pg8::EpiAny::gptr)(X); E.p2 = (pg8::EpiAny::gptr)((last && k == 6) ? (bf16_t*)nullptr : XB); E.p3 = (pg8::EpiAny::gptr)(ssq_out); E.p4 = (pg8::EpiAny::gptr)(gate_l); E.p5 = (pg8::EpiAny::gptr)(bias); E.p6 = (pg8::EpiAny::gptr)(gn_l); }
                pg8::StaticOrder S; S.init(g.M, g.N, (int)gridDim.x, (int)blockIdx.x);
#ifndef DIS_G1
                pg8::gemm_phase<pg8::EpiAny, pg8::StaticOrder, true, true>(lds, g, S, E);
#endif
                if (k == 2 && conv) { __syncthreads();
                    CtxGlu CE{UB, SSQ + (size_t)(3 * layer + 1) * NR, CB + (size_t)((layer * 3 + 1) * 2 + 1) * 5632};
#ifndef DIS_C1
                    ctx_gemm<2, 4, CtxGlu>(lds, XB + (size_t)T_LAT * 1024, g.Bt, 1024, 32, CE);
#endif
                } else if (k == 2) { __syncthreads();
                    CtxQkv CE{QKV, SSQ + (size_t)(3 * layer + 1) * NR, CB + (size_t)((layer * 3 + 1) * 2 + 1) * 5632, 0.125f * LOG2E};
#ifndef DIS_C2
                    ctx_gemm<1, 4, CtxQkv>(lds, XB + (size_t)T_LAT * 1024, g.Bt, 1024, last ? 64 : 96, CE, last ? 32 : 0);
#endif
                } else if ((k == 1 || k == 4 || k == 6) && !(last && k >= 4)) { __syncthreads();
                    CtxResid CE{first ? a.in[2] : XC, XC, XB, ssq_out, gate_l + 1024, bias, gn_l + 1024, dry};
#ifndef DIS_C3
                    if (g.K == 1024) ctx_gemm<1, 4, CtxResid>(lds, g.A + (size_t)T_LAT * 1024, g.Bt, 1024, 32, CE);
                    else ctx_gemm<1, 11, CtxResid>(lds, g.A + (size_t)T_LAT * FF, g.Bt, FF, 32, CE);
#endif
                }
            } else {
#ifndef DIS_CV
                if (conv) conv_mid(a, lds, j, UB, VB);
#endif
#ifndef DIS_AT
                if (!conv) attn_mid(a, lds, j, !last, QKV, OB);
#endif
            }
        }
        SEAM(2 + st);
#ifdef DUPMASK
        { const int layer2 = st / 7, k2 = st % 7; const bool dup_this2 = (((DUPMASK) >> k2) & 1) && (((DUPLAYERS) >> layer2) & 1);
          if (dup_this2 && !dup_second) { dup_second = true; --st; } else dup_second = false; }
#endif
    }
    if (IN(30)) {
        const Args& a = *args_ptr(); WS_PTRS(a);
        const int tid = opaque_tid(), w = tid >> 6, lane = tid & 63, gw = blockIdx.x * 8 + w, NGW = gridDim.x * 8;
        const float* ssq = SSQ + (size_t)12 * NR;
        f32x4 fg[4];
#pragma unroll
        for (int jj = 0; jj < 4; ++jj) fg[jj] = *(const f32x4*)(a.in[23] + 4 * lane + 256 * jj);
        for (int r0 = gw; r0 < T_LAT; r0 += 4 * NGW) {
            f32x4 v[4][4]; float rs[4];
#pragma unroll
            for (int q = 0; q < 4; ++q) { const int r = min(r0 + q * NGW, T_LAT - 1); rs[q] = ssq[r];
#pragma unroll
                for (int jj = 0; jj < 4; ++jj) v[q][jj] = *(const f32x4*)(X + (size_t)r * 1024 + 4 * lane + 256 * jj); }
#pragma unroll
            for (int q = 0; q < 4; ++q) { const int r = r0 + q * NGW; if (r < T_LAT) { const float sc = __builtin_amdgcn_rsqf(rs[q] * (1.0f / 1024.0f) + pg8::RMS_EPS_F);
#pragma unroll
                for (int jj = 0; jj < 4; ++jj) __builtin_nontemporal_store(v[q][jj] * sc * fg[jj], (f32x4*)(X + (size_t)r * 1024 + 4 * lane + 256 * jj)); } }
        }
    }
#undef IN
#undef SEAM
}

extern "C" void kernel_launch(void* const* d_in, const int* in_sizes, int n_in, void* d_out, int out_size, void* d_ws, size_t ws_size, hipStream_t stream) {
    static int grid = 0;
    if (grid == 0) {
        if (n_in != 24 || out_size != T_LAT * D || ws_size < WS_END) { fprintf(stderr, "kernel_launch: unexpected shapes (n_in %d out %d ws %zu)\n", n_in, out_size, ws_size); grid = -1; return; }
        int dev = 0, cus = 0, per_cu = 0;
        hipGetDevice(&dev); hipDeviceGetAttribute(&cus, hipDeviceAttributeMultiprocessorCount, dev);
        if (hipFuncSetAttribute((const void*)fwd_megakernel, hipFuncAttributeMaxDynamicSharedMemorySize, LDS_BYTES) != hipSuccess) { fprintf(stderr, "kernel_launch: hipFuncSetAttribute failed\n"); grid = -1; return; }
        if (hipOccupancyMaxActiveBlocksPerMultiprocessor(&per_cu, (const void*)fwd_megakernel, 512, LDS_BYTES) != hipSuccess || per_cu < 1) { fprintf(stderr, "kernel_launch: occupancy query gave %d\n", per_cu); per_cu = 1; }
        (void)hipGetLastError();
        grid = cus * (per_cu > 1 ? 1 : per_cu);
        if (grid <= 0) grid = 256;
    }
    if (grid < 0) return;
    if (hipMemsetAsync((char*)d_ws + WS_BAR, 0, XCD_BAR_WORDS * 4, stream) != hipSuccess) { fprintf(stderr, "kernel_launch: memset of the barrier words failed\n"); return; }
    Args a{};
    for (int i = 0; i < 24; ++i) a.in[i] = (const float*)d_in[i];
    a.out = (float*)d_out; a.ws = (unsigned char*)d_ws;
#if MK_SPLIT
    for (int p = 0; p < N_PHASES; ++p) { a.ph_lo = p; a.ph_hi = p + 1; hipLaunchKernelGGL(fwd_megakernel, dim3(grid), dim3(512), LDS_BYTES, stream, a); }
#else
    a.ph_lo = 0; a.ph_hi = N_PHASES;
    void* args[] = {&a};
    hipError_t e = hipLaunchCooperativeKernel((const void*)fwd_megakernel, dim3(grid), dim3(512), args, LDS_BYTES, stream);
    if (e != hipSuccess) fprintf(stderr, "kernel_launch: cooperative launch failed: %s (grid %d)\n", hipGetErrorString(e), grid);
#endif
}
```

```cpp
#include <hip/hip_runtime.h>
#include <hip/hip_cooperative_groups.h>
#include <cstdio>
#include <cstdint>
namespace cg = cooperative_groups;
#ifndef MK_SPLIT
#define MK_SPLIT 0
#endif
namespace pg8 {
#define PG8_LAS __attribute__((address_space(3)))
__device__ __forceinline__ int pg8_tid();
typedef unsigned short bf16_t;
typedef short bf16x8 __attribute__((ext_vector_type(8)));
typedef float f32x4 __attribute__((ext_vector_type(4)));
typedef unsigned u32x4 __attribute__((ext_vector_type(4)));
constexpr int BM = 256, BK = 64, HALF = 128, HTB = HALF * BK * 2  , STAGE_BYTES = 8 * HTB, NXCD = 8, WGM = 8;

__host__ __device__ __forceinline__ int lds_byte(int r, int c) { const int st = (r >> 4) * 2 + (c >> 5), rr = r & 15, cc = c & 31, ob = rr * 64 + cc * 2; return st * 1024 + (ob ^ (((ob >> 9) & 1) << 5)); }
__host__ __device__ __forceinline__ void stage_rc(int b, int& R, int& C) { const int st = b / 1024, sb = b % 1024, swz = sb ^ (((sb >> 9) & 1) << 5); R = (st >> 1) * 16 + swz / 64; C = (st & 1) * 32 + (swz % 64) / 2; }
__host__ __device__ __forceinline__ int perm32(int rho) { const int n = rho >> 4, i = rho & 15; return 8 * (i >> 2) + 4 * n + (i & 3); }

struct Unit { int pm, pn; };
struct Gemm { const bf16_t* A; const bf16_t* Bt; int M, N, K; };

struct StaticOrder {
    int nM, nN, nwg, G, c;
    __host__ __device__ void init(int M, int N, int G_, int c_) { nM = M / BM; nN = N / BM; nwg = nM * nN; G = G_; c = c_; }
    __host__ __device__ bool next(int i, Unit& u) const {
        const long L = (long)i * G + c; if (L >= nwg) return false;
        int wgid = (int)L; { const int q = nwg / NXCD, r = nwg % NXCD, xcd = wgid % NXCD, off = wgid / NXCD; wgid = (xcd < r ? xcd * (q + 1) : r * (q + 1) + (xcd - r) * q) + off; }
        const int nig = WGM * nN, gid = wgid / nig, fm = gid * WGM, gsz = (nM - fm) < WGM ? (nM - fm) : WGM;
        u.pm = fm + ((wgid % nig) % gsz); u.pn = (wgid % nig) / gsz; return true;
    }
    __device__ __forceinline__ void a_ready(const Unit&) const {}
    __device__ __forceinline__ void done(const Unit&) const {}
};

__device__ __forceinline__ unsigned cvt_pk_bf16(float lo, float hi) { unsigned r; asm volatile("v_cvt_pk_bf16_f32 %0, %1, %2" : "=v"(r) : "v"(lo), "v"(hi)); return r; }
typedef float f32x2 __attribute__((ext_vector_type(2)));
typedef float f32x2 __attribute__((ext_vector_type(2)));
typedef float f32x16 __attribute__((ext_vector_type(16)));
constexpr float RMS_EPS_F = 1e-6f;
__device__ __forceinline__ float sigmoid_f(float z) { return __builtin_amdgcn_rcpf(1.f + __builtin_amdgcn_exp2f(-1.44269504f * z)); }

template <int MODE> struct EpiGated {
    static constexpr bool PERM = true, AFTER_DRAIN = false;
    bf16_t* O; int ldc; const float* ssq; const float* cb_lat; const float* cb_ctx;
    __device__ __forceinline__ void operator()(const f32x4 (&acc)[2][2][4][2], const Unit& u, int wr, int wc, int fr, int fq) const {
        const float* cb = (u.pm >= 64) ? cb_ctx : cb_lat;
        const int row0 = u.pm * BM + wr * 64 + fr, bcol0 = u.pn * BM + wc * 32 + 8 * fq, ocol = u.pn * HALF + wc * 32 + 8 * fq;
        constexpr float NL2E = -1.44269504f;
        f32x2 b0[4], b1[4], bz[4];
#pragma unroll
        for (int n = 0; n < 2; ++n) { const f32x4 x0 = *(const f32x4*)(cb + bcol0 + 4 * n), x1 = *(const f32x4*)(cb + bcol0 + HALF + 4 * n);
            b0[2 * n] = (f32x2){x0[0], x0[1]}; b0[2 * n + 1] = (f32x2){x0[2], x0[3]}; b1[2 * n] = (f32x2){x1[0], x1[1]}; b1[2 * n + 1] = (f32x2){x1[2], x1[3]}; }
#pragma unroll
        for (int p = 0; p < 4; ++p) bz[p] = (MODE == 0 ? b0[p] : b1[p]) * NL2E;
        float sq[2][4];
#pragma unroll
        for (int ai = 0; ai < 2; ++ai)
#pragma unroll
            for (int m = 0; m < 4; ++m) sq[ai][m] = ssq[row0 + ai * HALF + m * 16];
#pragma unroll
        for (int ai = 0; ai < 2; ++ai)
#pragma unroll
            for (int m = 0; m < 4; ++m) {
                const int row = row0 + ai * HALF + m * 16;
                const float rs = __builtin_amdgcn_rsqf(sq[ai][m] * (1.0f / 1024.0f) + RMS_EPS_F), rz = rs * NL2E;
                unsigned w[4];
#pragma unroll
                for (int p = 0; p < 4; ++p) {
                    const f32x4 a0 = acc[ai][0][m][p >> 1], a1 = acc[ai][1][m][p >> 1];
                    const f32x2 c0 = (p & 1) ? (f32x2){a0[2], a0[3]} : (f32x2){a0[0], a0[1]}, c1 = (p & 1) ? (f32x2){a1[2], a1[3]} : (f32x2){a1[0], a1[1]};
                    const f32x2 v0 = c0 * rs + b0[p], v1 = c1 * rs + b1[p];
                    const f32x2 t = (MODE == 0 ? c0 : c1) * rz + bz[p];
                    f32x2 d; d.x = __builtin_amdgcn_exp2f(t.x); d.y = __builtin_amdgcn_exp2f(t.y); d = d + 1.0f;
                    f32x2 r; r.x = __builtin_amdgcn_rcpf(d.x); r.y = __builtin_amdgcn_rcpf(d.y);
                    const f32x2 o = (MODE == 0) ? (v0 * v1) * r : v0 * r;
                    w[p] = cvt_pk_bf16(o.x, o.y);
                }
                u32x4 wv; wv.x = w[0]; wv.y = w[1]; wv.z = w[2]; wv.w = w[3];
                *(u32x4*)(O + ((unsigned)row * (unsigned)ldc + (unsigned)ocol)) = wv;
            }
    }
};
struct EpiQKV {
    static constexpr bool PERM = true, AFTER_DRAIN = false;
    bf16_t* O; const float* ssq; const float* cb; float qscale;
    __device__ __forceinline__ void operator()(const f32x4 (&acc)[2][2][4][2], const Unit& u, int wr, int wc, int fr, int fq) const {
        const int row0 = u.pm * BM + wr * 64 + fr, col0 = u.pn * BM + wc * 32 + 8 * fq;
        f32x4 bv[2][2];
#pragma unroll
        for (int bj = 0; bj < 2; ++bj)
#pragma unroll
            for (int n = 0; n < 2; ++n) bv[bj][n] = *(const f32x4*)(cb + col0 + bj * HALF + 4 * n);
        const float sc = (u.pn < 4) ? qscale : 1.f;
        float sq[2][4];
#pragma unroll
        for (int ai = 0; ai < 2; ++ai)
#pragma unroll
            for (int m = 0; m < 4; ++m) sq[ai][m] = ssq[row0 + ai * HALF + m * 16];
#pragma unroll
        for (int ai = 0; ai < 2; ++ai)
#pragma unroll
            for (int m = 0; m < 4; ++m) {
                const int row = row0 + ai * HALF + m * 16;
                const float rs = __builtin_amdgcn_rsqf(sq[ai][m] * (1.0f / 1024.0f) + RMS_EPS_F);
#pragma unroll
                for (int bj = 0; bj < 2; ++bj) {
                    const f32x4 v0 = (acc[ai][bj][m][0] * rs + bv[bj][0]) * sc, v1 = (acc[ai][bj][m][1] * rs + bv[bj][1]) * sc;
                    u32x4 w; w.x = cvt_pk_bf16(v0[0], v0[1]); w.y = cvt_pk_bf16(v0[2], v0[3]); w.z = cvt_pk_bf16(v1[0], v1[1]); w.w = cvt_pk_bf16(v1[2], v1[3]);
                    *(u32x4*)(O + ((unsigned)row * 3072u + (unsigned)(col0 + bj * HALF))) = w;
                }
            }
    }
};
struct EpiResid {
    static constexpr bool PERM = true, AFTER_DRAIN = false;
    const float* xold; float* xnew; bf16_t* xb; float* ssq_out; const float* gate; const float* bias; const float* gn; bool dry;
    __device__ __forceinline__ void operator()(const f32x4 (&acc)[2][2][4][2], const Unit& u, int wr, int wc, int fr, int fq) const {
        const int row0 = u.pm * BM + wr * 64 + fr, col0 = u.pn * BM + wc * 32 + 8 * fq;
        float ss[2][4];
#pragma unroll
        for (int ai = 0; ai < 2; ++ai)
#pragma unroll
            for (int m = 0; m < 4; ++m) ss[ai][m] = 0.f;
#pragma unroll
        for (int bj = 0; bj < 2; ++bj) {
            const int c = col0 + bj * HALF;
            const f32x4 g0 = *(const f32x4*)(gate + c), g1 = *(const f32x4*)(gate + c + 4), n0 = *(const f32x4*)(gn + c), n1 = *(const f32x4*)(gn + c + 4);
            const f32x4 b0 = bias ? *(const f32x4*)(bias + c) : (f32x4){0.f, 0.f, 0.f, 0.f}, b1 = bias ? *(const f32x4*)(bias + c + 4) : (f32x4){0.f, 0.f, 0.f, 0.f};
#pragma unroll
            for (int ai = 0; ai < 2; ++ai) {
                f32x4 xa[4][2];
#pragma unroll
                for (int m = 0; m < 4; ++m) { const unsigned off = (unsigned)(row0 + ai * HALF + m * 16) * 1024u + (unsigned)c; xa[m][0] = *(const f32x4*)(xold + off); xa[m][1] = *(const f32x4*)(xold + off + 4); }
#pragma unroll
                for (int m = 0; m < 4; ++m) {
                    const unsigned off = (unsigned)(row0 + ai * HALF + m * 16) * 1024u + (unsigned)c;
                    const f32x4 x0 = xa[m][0], x1 = xa[m][1];
                    const f32x4 y0 = x0 + g0 * (acc[ai][bj][m][0] + b0), y1 = x1 + g1 * (acc[ai][bj][m][1] + b1);
                    if (!dry) { *(f32x4*)(xnew + off) = y0; *(f32x4*)(xnew + off + 4) = y1; }
                    ss[ai][m] += (y0[0] * y0[0] + y0[1] * y0[1]) + (y0[2] * y0[2] + y0[3] * y0[3]) + (y1[0] * y1[0] + y1[1] * y1[1]) + (y1[2] * y1[2] + y1[3] * y1[3]);
                    asm volatile("" : "+v"(ss[ai][m]));
                    const f32x4 z0 = y0 * n0, z1 = y1 * n1;
                    u32x4 w; w.x = cvt_pk_bf16(z0[0], z0[1]); w.y = cvt_pk_bf16(z0[2], z0[3]); w.z = cvt_pk_bf16(z1[0], z1[1]); w.w = cvt_pk_bf16(z1[2], z1[3]);
                    if (!dry && xb) *(u32x4*)(xb + off) = w;
                }
                asm volatile("" ::: "memory");
            }
        }
#pragma unroll
        for (int ai = 0; ai < 2; ++ai)
#pragma unroll
            for (int m = 0; m < 4; ++m) { float sv = ss[ai][m]; sv += __shfl_xor(sv, 16); sv += __shfl_xor(sv, 32); if (fq == 0 && !dry) atomicAdd(ssq_out + row0 + ai * HALF + m * 16, sv); }
    }
};

struct EpiAny {
    static constexpr bool PERM = true, AFTER_DRAIN = false;
    int kind;
    typedef const __attribute__((address_space(1))) void* gptr;
    gptr p0, p1, p2, p3, p4, p5, p6; int i0; float f0; bool dry;
    __device__ __forceinline__ void operator()(const f32x4 (&acc)[2][2][4][2], const Unit& u, int wr, int wc, int fr, int fq) const {
        gptr q0 = p0, q1 = p1, q2 = p2, q3 = p3;
        if (kind == 0) { asm volatile("" : "+s"(q0), "+s"(q1), "+s"(q2), "+s"(q3)); const EpiGated<0> E{(bf16_t*)q0, i0, (const float*)q1, (const float*)q2, (const float*)q3}; E(acc, u, wr, wc, fr, fq); }
        else if (kind == 1) { asm volatile("" : "+s"(q0), "+s"(q1), "+s"(q2), "+s"(q3)); const EpiGated<1> E{(bf16_t*)q0, i0, (const float*)q1, (const float*)q2, (const float*)q3}; E(acc, u, wr, wc, fr, fq); }
        else if (kind == 2) { asm volatile("" : "+s"(q0), "+s"(q1), "+s"(q2)); const EpiQKV E{(bf16_t*)q0, (const float*)q1, (const float*)q2, f0}; E(acc, u, wr, wc, fr, fq); }
        else { asm volatile("" : "+s"(q0), "+s"(q1), "+s"(q2), "+s"(q3)); const EpiResid E{(const float*)q0, (float*)q1, (bf16_t*)q2, (float*)q3, (const float*)p4, (const float*)p5, (const float*)p6, dry}; E(acc, u, wr, wc, fr, fq); }
    }
};
template <class Epi, class Sched, bool ALIGN_EPI = false, bool SP2 = false>
__device__ __forceinline__ void gemm_phase(PG8_LAS unsigned char* lds, const Gemm g, const Sched& S, const Epi& E) {
    int tid_l = pg8_tid();
    const int tid = tid_l, wid = __builtin_amdgcn_readfirstlane(tid >> 6), lane = tid & 63, wr = wid >> 2, wc = wid & 3, fr = lane & 15, fq = lane >> 4;
    const int K = g.K, nt = K / BK;
    unsigned voffA[2], voffB[2];
#pragma unroll
    for (int i = 0; i < 2; ++i) { int R, C; stage_rc(tid * 16 + i * 8192, R, C); const int Rb = Epi::PERM ? ((R & ~31) + perm32(R & 31)) : R;
        voffA[i] = (unsigned)(R * K + C) * 2u; voffB[i] = (unsigned)(Rb * K + C) * 2u; }
    const size_t kstep = (size_t)(BK * 2);
    const size_t hstep = (size_t)HALF * K * 2;
    const size_t tstep = 2 * hstep;
    const unsigned ldsw = (unsigned)wid * 1024u;
    const int aoff = lds_byte(wr * 64 + fr, fq * 8), boff = lds_byte(wc * 32 + fr, fq * 8);
#define PG8_SA(b, h) (((b) * 2 + (h)) * HTB)
#define PG8_SB(b, h) ((4 + (b) * 2 + (h)) * HTB)
#define PG8_STAGE(bufoff, gbase, voff) do { _Pragma("unroll") for (int _i = 0; _i < 2; ++_i) \
        __builtin_amdgcn_global_load_lds((const unsigned*)((const char*)(gbase) + (voff)[_i]), (PG8_LAS unsigned*)(lds + (bufoff) + ldsw + _i * 8192), 16, 0, 0); } while (0)
#define PG8_LDA(dst, b, h) do { _Pragma("unroll") for (int m = 0; m < 4; ++m) _Pragma("unroll") for (int k = 0; k < 2; ++k) dst[m][k] = *(const PG8_LAS bf16x8*)(lds + PG8_SA(b, h) + aoff + m * 2048 + k * 1024); } while (0)
#define PG8_LDB(dst, b, h) do { _Pragma("unroll") for (int n = 0; n < 2; ++n) _Pragma("unroll") for (int k = 0; k < 2; ++k) dst[n][k] = *(const PG8_LAS bf16x8*)(lds + PG8_SB(b, h) + boff + n * 2048 + k * 1024); } while (0)
#define PG8_MMA(ai, bj, At, Bt) do { __builtin_amdgcn_s_setprio(1); _Pragma("unroll") for (int m = 0; m < 4; ++m) _Pragma("unroll") for (int n = 0; n < 2; ++n) _Pragma("unroll") for (int k = 0; k < 2; ++k) \
        acc[ai][bj][m][n] = __builtin_amdgcn_mfma_f32_16x16x32_bf16(Bt[n][k], At[m][k], acc[ai][bj][m][n], 0, 0, 0); __builtin_amdgcn_s_setprio(0); } while (0)
#define PG8_WAIT_V(n) asm volatile("s_waitcnt vmcnt(" #n ")" ::: "memory")
#define PG8_WAIT_L(n) asm volatile("s_waitcnt lgkmcnt(" #n ")" ::: "memory")
#define PG8_BAR __builtin_amdgcn_s_barrier()
#define PG8_SCHED __builtin_amdgcn_sched_barrier(0)
    Unit cur, nxt; int ui = 0;
    if (!S.next(0, cur)) return;
    f32x4 acc[2][2][4][2];
#pragma unroll
    for (int a = 0; a < 2; ++a)
#pragma unroll
        for (int b = 0; b < 2; ++b)
#pragma unroll
            for (int m = 0; m < 4; ++m)
#pragma unroll
                for (int n = 0; n < 2; ++n) acc[a][b][m][n] = (f32x4){0.f, 0.f, 0.f, 0.f};
    bf16x8 At[4][2], B0[2][2], B1[2][2];
    const char* cA = (const char*)g.A + (size_t)cur.pm * tstep; const char* cB = (const char*)g.Bt + (size_t)cur.pn * tstep;
    S.a_ready(cur);
    if constexpr (SP2) {
        PG8_STAGE(PG8_SB(0, 0), cB, voffB); PG8_STAGE(PG8_SB(0, 1), cB + hstep, voffB); PG8_STAGE(PG8_SA(0, 0), cA, voffA); PG8_STAGE(PG8_SA(0, 1), cA + hstep, voffA);
        if (wr == 1) PG8_BAR;
        PG8_WAIT_V(2); PG8_BAR;
        PG8_STAGE(PG8_SB(1, 0), cB + kstep, voffB); PG8_STAGE(PG8_SA(1, 0), cA + kstep, voffA); PG8_STAGE(PG8_SB(1, 1), cB + hstep + kstep, voffB);
        PG8_WAIT_V(6); PG8_BAR;
    } else {
        PG8_STAGE(PG8_SB(0, 0), cB, voffB); PG8_STAGE(PG8_SA(0, 0), cA, voffA); PG8_STAGE(PG8_SB(0, 1), cB + hstep, voffB); PG8_STAGE(PG8_SA(0, 1), cA + hstep, voffA);
        if (wr == 1) PG8_BAR;
        PG8_WAIT_V(4); PG8_BAR;
        PG8_STAGE(PG8_SB(1, 0), cB + kstep, voffB); PG8_STAGE(PG8_SA(1, 0), cA + kstep, voffA); PG8_STAGE(PG8_SB(1, 1), cB + hstep + kstep, voffB);
        PG8_WAIT_V(6); PG8_BAR;
    }
    for (;;) {
        const bool has_next = S.next(ui + 1, nxt);
        const char* nA = has_next ? (const char*)g.A + (size_t)nxt.pm * tstep : cA; const char* nB = has_next ? (const char*)g.Bt + (size_t)nxt.pn * tstep : cB;
        for (int t = 0; t < nt; t += 2) {
            const bool last = (t == nt - 2);
            const char* a1 = cA + (size_t)(t + 1) * kstep;
            const char* a2 = last ? nA : cA + (size_t)(t + 2) * kstep; const char* b2 = last ? nB : cB + (size_t)(t + 2) * kstep;
            const char* a3 = a2 + kstep; const char* b3 = b2 + kstep;
            if (last && has_next) S.a_ready(nxt);
            if constexpr (SP2) {
            PG8_LDB(B0, 0, 0); PG8_LDB(B1, 0, 1); PG8_SCHED; PG8_LDA(At, 0, 0); PG8_STAGE(PG8_SA(1, 1), a1 + hstep, voffA);
            PG8_WAIT_V(8); PG8_WAIT_L(0); PG8_BAR; PG8_MMA(0, 0, At, B0); PG8_MMA(0, 1, At, B1); PG8_BAR; PG8_SCHED;
            PG8_LDA(At, 0, 1); PG8_STAGE(PG8_SB(0, 0), b2, voffB); PG8_STAGE(PG8_SB(0, 1), b2 + hstep, voffB); PG8_STAGE(PG8_SA(0, 0), a2, voffA);
            PG8_WAIT_V(8); PG8_WAIT_L(0); PG8_BAR; PG8_MMA(1, 0, At, B0); PG8_MMA(1, 1, At, B1); PG8_BAR; PG8_SCHED;
            PG8_LDB(B0, 1, 0); PG8_LDB(B1, 1, 1); PG8_SCHED; PG8_LDA(At, 1, 0); PG8_STAGE(PG8_SA(0, 1), a2 + hstep, voffA);
            PG8_WAIT_V(8); PG8_WAIT_L(0); PG8_BAR; PG8_MMA(0, 0, At, B0); PG8_MMA(0, 1, At, B1); PG8_BAR; PG8_SCHED;
            PG8_LDA(At, 1, 1); PG8_STAGE(PG8_SB(1, 0), b3, voffB); PG8_STAGE(PG8_SB(1, 1), b3 + hstep, voffB); PG8_STAGE(PG8_SA(1, 0), a3, voffA);
            PG8_WAIT_V(8); PG8_WAIT_L(0); PG8_BAR; PG8_MMA(1, 0, At, B0); PG8_MMA(1, 1, At, B1); PG8_BAR; PG8_SCHED;
            } else {
            PG8_LDB(B0, 0, 0); PG8_SCHED; PG8_LDA(At, 0, 0); PG8_STAGE(PG8_SA(1, 1), a1 + hstep, voffA);
            PG8_WAIT_L(8); PG8_BAR; PG8_WAIT_L(0); PG8_MMA(0, 0, At, B0); PG8_BAR; PG8_SCHED;
            PG8_LDB(B1, 0, 1); PG8_STAGE(PG8_SB(0, 0), b2, voffB);
            PG8_BAR; PG8_WAIT_L(0); PG8_MMA(0, 1, At, B1); PG8_BAR;
            PG8_LDA(At, 0, 1); PG8_STAGE(PG8_SA(0, 0), a2, voffA);
            PG8_BAR; PG8_WAIT_L(0); PG8_MMA(1, 0, At, B0); PG8_BAR; PG8_SCHED;
            PG8_STAGE(PG8_SB(0, 1), b2 + hstep, voffB);
            PG8_WAIT_V(6); PG8_BAR; PG8_MMA(1, 1, At, B1); PG8_BAR;
            PG8_LDB(B0, 1, 0); PG8_SCHED; PG8_LDA(At, 1, 0); PG8_STAGE(PG8_SA(0, 1), a2 + hstep, voffA);
            PG8_WAIT_L(8); PG8_BAR; PG8_WAIT_L(0); PG8_MMA(0, 0, At, B0); PG8_BAR; PG8_SCHED;
            PG8_LDB(B1, 1, 1); PG8_STAGE(PG8_SB(1, 0), b3, voffB);
            PG8_BAR; PG8_WAIT_L(0); PG8_MMA(0, 1, At, B1); PG8_BAR;
            PG8_LDA(At, 1, 1); PG8_STAGE(PG8_SA(1, 0), a3, voffA);
            PG8_BAR; PG8_WAIT_L(0); PG8_MMA(1, 0, At, B0); PG8_BAR; PG8_SCHED;
            PG8_STAGE(PG8_SB(1, 1), b3 + hstep, voffB);
            PG8_WAIT_V(6); PG8_BAR; PG8_MMA(1, 1, At, B1); PG8_BAR;
            }
        }
        if constexpr (ALIGN_EPI) { if (wr == 0) PG8_BAR; }
        if constexpr (!Epi::AFTER_DRAIN) { E(acc, cur, wr, wc, fr, fq); S.done(cur); }
        if (!has_next) break;
#pragma unroll
        for (int a = 0; a < 2; ++a)
#pragma unroll
            for (int b = 0; b < 2; ++b)
#pragma unroll
                for (int m = 0; m < 4; ++m)
#pragma unroll
                    for (int n = 0; n < 2; ++n) acc[a][b][m][n] = (f32x4){0.f, 0.f, 0.f, 0.f};
        cur = nxt; cA = nA; cB = nB; ++ui;
        if constexpr (ALIGN_EPI) { if (wr == 1) PG8_BAR; }
    }
    PG8_WAIT_V(0);
    if constexpr (!ALIGN_EPI) { if (wr == 0) PG8_BAR; }
    PG8_BAR;
    if constexpr (Epi::AFTER_DRAIN) { E.fused(acc, cur, wr, wc, fr, fq, lds, wid, lane); S.done(cur); }
#undef PG8_SA
#undef PG8_SB
#undef PG8_STAGE
#undef PG8_LDA
#undef PG8_LDB
#undef PG8_MMA
#undef PG8_WAIT_V
#undef PG8_WAIT_L
#undef PG8_BAR
#undef PG8_SCHED
}
}
using pg8::bf16_t; using pg8::bf16x8; using pg8::f32x4; using pg8::u32x4; using pg8::f32x2; using pg8::f32x16;
#define LAS __attribute__((address_space(3)))
typedef short v4i16_t __attribute__((ext_vector_type(4)));
typedef unsigned u32x2 __attribute__((ext_vector_type(2)));

constexpr int T_LAT = 16384, T_CTX = 256, NR = T_LAT + T_CTX, D = 1024, FF = 2816, NHEAD = 16;
constexpr int NSSQ = 13;
constexpr float LOG2E = 1.44269504f;
constexpr size_t MiB = 1u << 20;
constexpr size_t WS_MODS = 0;
constexpr size_t WS_CB = 1 * MiB;
constexpr size_t WS_GT = 2 * MiB;
constexpr size_t WS_GATE = 2 * MiB + 512 * 1024;
constexpr size_t WS_SSQ = 3 * MiB;
constexpr size_t WS_XC = 4 * MiB;
constexpr size_t WS_BAR = 6 * MiB;
constexpr size_t WS_W = 8 * MiB;
constexpr size_t W_GU = 0, W_D = W_GU + (size_t)8 * 5632 * 1024, W_PW1 = W_D + (size_t)8 * 1024 * 2816, W_PW2 = W_PW1 + (size_t)2 * 2048 * 1024,
                 W_QKV = W_PW2 + (size_t)2 * 1024 * 1024, W_O = W_QKV + (size_t)2 * 3072 * 1024, W_END = W_O + (size_t)2 * 1024 * 1024;
constexpr size_t WS_XB = 170 * MiB;
constexpr size_t WS_H = 203 * MiB;
constexpr size_t WS_QKV = 293 * MiB;
constexpr size_t WS_END = 391 * MiB;
static_assert(WS_W + W_END * 2 <= WS_XB && WS_XB + (size_t)NR * 1024 * 2 <= WS_H && WS_H + (size_t)NR * FF * 2 <= WS_QKV && WS_QKV + (size_t)NR * 3072 * 2 <= WS_END, "ws map");
constexpr int LDS_BYTES = 131072 + 8192;

struct Args { const float* in[24]; float* out; unsigned char* ws; int ph_lo, ph_hi; };

__device__ __forceinline__ float wave_sum(float v) {
#pragma unroll
    for (int o = 1; o < 64; o <<= 1) v += __shfl_xor(v, o);
    return v;
}
extern __shared__ __attribute__((aligned(16))) unsigned char lds_raw[];
constexpr int LDS_TIDTAB = 131072 + 4096 + 64;
__device__ __forceinline__ unsigned hw_wave_key() { return (unsigned)__builtin_amdgcn_s_getreg((5 << 11) | 4) & 63u; }
__device__ __forceinline__ int opaque_tid() {
    const unsigned wv = ((const LAS unsigned*)((LAS unsigned char*)lds_raw + LDS_TIDTAB))[hw_wave_key()];
    unsigned ones = ~0u; asm volatile("" : "+s"(ones));
    int t = (int)(__builtin_amdgcn_readfirstlane(wv) * 64u + __builtin_amdgcn_mbcnt_hi(ones, __builtin_amdgcn_mbcnt_lo(ones, 0u)));
    asm volatile("" : "+v"(t)); return t;
}
__device__ __forceinline__ float bf_lo(unsigned u) { return __uint_as_float(u << 16); }
__device__ __forceinline__ float bf_hi(unsigned u) { return __uint_as_float(u & 0xffff0000u); }
using pg8::cvt_pk_bf16; using pg8::sigmoid_f;
__device__ __forceinline__ int pg8::pg8_tid() { return opaque_tid(); }

#define XB_TMO      128
#define XB_XCNT(j)  (256  + 64 * (j))
#define XB_XSUB(j)  (1280 + 64 * (j))
#define XB_XGEN(j)  (2304 + 64 * (j))
#define XB_TOP      3328
#define XB_TOPGEN   3392
#define XCD_BAR_WORDS 3456
#define XB_SPIN_CAP (1u << 18)

__device__ __forceinline__ unsigned xb_ld(unsigned* p)              { return __hip_atomic_load(p, __ATOMIC_RELAXED, __HIP_MEMORY_SCOPE_AGENT); }
__device__ __forceinline__ unsigned xb_add(unsigned* p, unsigned v) { return __hip_atomic_fetch_add(p, v, __ATOMIC_RELAXED, __HIP_MEMORY_SCOPE_AGENT); }
__device__ __forceinline__ unsigned xb_xcc_id() { return (unsigned)__builtin_amdgcn_s_getreg((3 << 11) | 20) & 0xFu; }
#define XB_SPIN(cond, bar) do { unsigned _sp = 0; while (cond) { __builtin_amdgcn_s_sleep(1); \
    if ((++_sp & 255u) == 0u) { if (xb_ld(&(bar)[XB_TMO])) break; if (_sp > XB_SPIN_CAP) { atomicAdd(&(bar)[XB_TMO], 1u); break; } } } } while (0)

struct XcdBarrier {
    unsigned* bar; unsigned x;
    volatile LAS unsigned* st;
};

__device__ __forceinline__ XcdBarrier xcd_barrier_post(unsigned* bar, volatile LAS unsigned* st) {
    XcdBarrier b; b.bar = bar; b.x = xb_xcc_id(); b.st = st;
    if (threadIdx.x == 0) (void)xb_add(&bar[XB_XCNT(b.x)], 1u);
    return b;
}
__device__ __forceinline__ void xcd_barrier_complete(unsigned* bar, unsigned x, unsigned& nloc, unsigned& nx) {
    const unsigned G = gridDim.x * gridDim.y * gridDim.z;
    unsigned sum, cnt, mine, sp = 0u;
    for (;;) {
        sum = 0u; cnt = 0u; mine = 0u;
#pragma unroll
        for (unsigned j = 0; j < 16; ++j) { const unsigned c = xb_ld(&bar[XB_XCNT(j)]); sum += c; cnt += (c > 0u) ? 1u : 0u; mine = (j == x) ? c : mine; }
        if (sum == G) break;
        __builtin_amdgcn_s_sleep(1);
        if ((++sp & 255u) == 0u) { if (xb_ld(&bar[XB_TMO])) break; if (sp > XB_SPIN_CAP) { atomicAdd(&bar[XB_TMO], 1u); break; } }
    }
    nloc = mine > 0u ? mine : 1u; nx = cnt > 0u ? cnt : 1u;
}

__device__ __forceinline__ void xcd_barrier(const XcdBarrier& b) {
    asm volatile("s_waitcnt vmcnt(0)" ::: "memory");
    __syncthreads();
    if (threadIdx.x == 0) {
        unsigned* bar = b.bar;
        __builtin_amdgcn_s_waitcnt(0);
        unsigned nloc = b.st[0], nx = b.st[1];
        if (nloc == 0u) { xcd_barrier_complete(bar, b.x, nloc, nx); b.st[0] = nloc; b.st[1] = nx; }
        const unsigned old = xb_add(&bar[XB_XSUB(b.x)], 1u);
        const unsigned gen = old / nloc;
        if (old + 1u == (gen + 1u) * nloc) {
            __builtin_amdgcn_fence(__ATOMIC_RELEASE, "agent");
            asm volatile("s_waitcnt vmcnt(0)" ::: "memory");
            const unsigned og = xb_add(&bar[XB_TOP], 1u);
            const unsigned tg = og / nx;
            if (og + 1u == (tg + 1u) * nx) xb_add(&bar[XB_TOPGEN], 1u);
            else XB_SPIN(xb_ld(&bar[XB_TOPGEN]) == tg, bar);
            __builtin_amdgcn_fence(__ATOMIC_ACQUIRE, "agent");
            xb_add(&bar[XB_XGEN(b.x)], 1u);
            asm volatile("s_waitcnt vmcnt(0)" ::: "memory");
        } else {
            XB_SPIN(xb_ld(&bar[XB_XGEN(b.x)]) == gen, bar);
            __builtin_amdgcn_fence(__ATOMIC_ACQUIRE, "agent");
            asm volatile("s_waitcnt vmcnt(0)" ::: "memory");
        }
    }
    __syncthreads();
}

__device__ __forceinline__ void prologue_a(const Args& a, LAS unsigned char* lds, float* MODS, float* CB, float* SSQ) {
    const int tid = opaque_tid(), G = gridDim.x, b = blockIdx.x;
    for (int i = b * 512 + tid; i < NSSQ * NR; i += G * 512) SSQ[i] = 0.f;
    for (int i = b * 512 + tid; i < 4 * 3 * 2 * 5632; i += G * 512) {
        const int n = i % 5632, r = i / 5632, ls = r >> 1, slot = ls % 3, layer = ls / 3;
        float v = 0.f;
        if (slot == 1) { const int j = layer >> 1;
            if ((layer & 1) == 0) { if (n < 2048) { const int pnb = n >> 8, bj = (n >> 7) & 1, jj = n & 127; v = a.in[11][j * 2048 + bj * 1024 + pnb * 128 + jj]; } }
            else { if (n < 3072) v = a.in[19][j * 3072 + n]; } }
        CB[i] = v;
    }
    LAS float* sl = (LAS float*)lds;
    LAS float* red = (LAS float*)(lds + 8192);
    for (int t = tid; t < 2048; t += 512) { const float v = t < 1024 ? a.in[1][t] : a.in[3][t - 1024]; sl[t] = v * sigmoid_f(v); }
    __syncthreads();
    const int w = tid >> 6, lane = tid & 63;
    for (int unit = b; unit < 256; unit += G) {
        const int layer = unit >> 6, c0 = (unit & 63) * 144;
        if (lane < 36) {
            f32x4 al = {0.f, 0.f, 0.f, 0.f}, ac = {0.f, 0.f, 0.f, 0.f};
            const float* wp = a.in[4] + ((size_t)layer * 1024 + w * 128) * 9216 + c0 + 4 * lane;
#pragma unroll 16
            for (int k = 0; k < 128; ++k) { const f32x4 wv = __builtin_nontemporal_load((const f32x4*)(wp + (size_t)k * 9216)); al += wv * sl[w * 128 + k]; ac += wv * sl[1024 + w * 128 + k]; }
            LAS float* r = red + (w * 36 + lane) * 8;
            r[0] = al[0]; r[1] = al[1]; r[2] = al[2]; r[3] = al[3]; r[4] = ac[0]; r[5] = ac[1]; r[6] = ac[2]; r[7] = ac[3];
        }
        __syncthreads();
        if (tid < 288) { const int st = tid / 144, col = tid % 144; float s = 0.f;
#pragma unroll
            for (int w2 = 0; w2 < 8; ++w2) s += red[(w2 * 36 + (col >> 2)) * 8 + st * 4 + (col & 3)];
            s += a.in[5][layer * 9216 + c0 + col];
            MODS[(layer * 2 + st) * 9216 + c0 + col] = s; }
        __syncthreads();
    }
}

struct ConvDesc { const float* src; bf16_t* dst; float* cbl; const float* shl; int K, N, k0, n0, drow; };
__device__ __forceinline__ void convert_load(const ConvDesc& d, int lane, f32x4 (&v)[8], f32x2& sh) {
    const int kr = lane >> 3, c4 = lane & 7;
#pragma unroll
    for (int i = 0; i < 8; ++i) v[i] = __builtin_nontemporal_load((const f32x4*)(d.src + (size_t)(d.k0 + 8 * i + kr) * d.N + d.n0 + 4 * c4));
    sh = (f32x2){0.f, 0.f};
    if (d.cbl) { sh.x = d.shl[d.k0 + lane]; sh.y = d.shl[9216 + d.k0 + lane]; }
}
__device__ __forceinline__ void convert_finish(const ConvDesc& d, const f32x4 (&v)[8], const f32x2& shv, LAS float* scr, int lane, bool nts) {
    const float* src = d.src; (void)src; const int K = d.K, k0 = d.k0, drow = d.drow; bf16_t* dst = d.dst; float* cbl = d.cbl; float* cbc = cbl ? cbl + 5632 : nullptr; const float* shl = d.shl; const float* shc = shl ? shl + 9216 : nullptr;
    { const int kr = lane >> 3, c4 = lane & 7;
#pragma unroll
      for (int i = 0; i < 8; ++i) { LAS float* p = scr + (8 * i + kr) * 33 + 4 * c4; p[0] = v[i][0]; p[1] = v[i][1]; p[2] = v[i][2]; p[3] = v[i][3]; }
      scr[2112 + lane] = shv.x; scr[2176 + lane] = shv.y; }
    asm volatile("s_waitcnt lgkmcnt(0)" ::: "memory");
    const int c = lane & 7;
#pragma unroll
    for (int j = 0; j < 4; ++j) { const int n = (lane >> 3) + 8 * j; const LAS float* s = scr + (8 * c) * 33 + n;
        u32x4 o; o.x = cvt_pk_bf16(s[0 * 33], s[1 * 33]); o.y = cvt_pk_bf16(s[2 * 33], s[3 * 33]); o.z = cvt_pk_bf16(s[4 * 33], s[5 * 33]); o.w = cvt_pk_bf16(s[6 * 33], s[7 * 33]);
        u32x4* dp = (u32x4*)(dst + (size_t)(drow + n) * K + k0 + 8 * c); if (nts) __builtin_nontemporal_store(o, dp); else *dp = o; }
    if (cbl) {
        const int n = lane & 31; const LAS float* sh = scr + ((lane < 32) ? 2112 : 2176); float acc = 0.f; (void)shl; (void)shc;
#pragma unroll 16
        for (int k = 0; k < 64; ++k) acc += scr[k * 33 + n] * sh[k];
        atomicAdd(((lane < 32) ? cbl : cbc) + drow + n, acc);
    }
    asm volatile("s_waitcnt lgkmcnt(0)" ::: "memory");
}
__device__ __forceinline__ int layer_items(int L) { return (L & 1) ? 10496 : 9984; }
__device__ __forceinline__ int layer_item_to_global(int L, int idx) {
    if (idx < 8448) { const int ml = idx / 1408, typ = ml >> 1, s = ml & 1; return (typ * 8 + L * 2 + s) * 1408 + idx % 1408; }
    const int r = idx - 8448, j = L >> 1;
    if ((L & 1) == 0) return r < 1024 ? 33792 + j * 1024 + r : 33792 + 2048 + j * 512 + (r - 1024);
    return r < 1536 ? 33792 + 3072 + j * 1536 + r : 33792 + 6144 + j * 512 + (r - 1536);
}
__device__ __forceinline__ ConvDesc convert_decode(const Args& a, int it, const float* MODS, float* CB, bf16_t* W) {

        const float* src; int K, N, k0, n0, drow; bf16_t* dst; float* cbl = nullptr; const float* shl = nullptr;
        if (it < 33792) {
            const int mtx = it / 1408, r = it % 1408, typ = mtx >> 3, idx = mtx & 7;
            if (typ < 2) { K = 1024; N = FF; k0 = (r / 88) * 64; n0 = (r % 88) * 32; src = a.in[7 + typ] + (size_t)idx * 1024 * FF; dst = W + W_GU + (size_t)idx * 5632 * 1024;
                drow = 256 * (n0 >> 7) + (n0 & 127) + 128 * typ; const int layer = idx >> 1, slot = (idx & 1) * 2;
                cbl = CB + (size_t)((layer * 3 + slot) * 2) * 5632; shl = MODS + (layer * 2) * 9216 + (slot == 0 ? 0 : 6) * 1024; }
            else { K = FF; N = 1024; k0 = (r / 32) * 64; n0 = (r % 32) * 32; src = a.in[9] + (size_t)idx * FF * 1024; dst = W + W_D + (size_t)idx * 1024 * FF; drow = n0; }
        } else {
            int r = it - 33792; K = 1024;
            if (r < 2048) { const int j = r >> 10; r &= 1023; N = 2048; k0 = (r >> 6) * 64; n0 = (r & 63) * 32; src = a.in[10] + (size_t)j * 1024 * 2048; dst = W + W_PW1 + (size_t)j * 2048 * 1024;
                const int n1 = n0 & 1023; drow = 256 * (n1 >> 7) + (n1 & 127) + (n0 >= 1024 ? 128 : 0);
                cbl = CB + (size_t)(((2 * j) * 3 + 1) * 2) * 5632; shl = MODS + ((2 * j) * 2) * 9216 + 3 * 1024; }
            else if (r < 3072) { r -= 2048; const int j = r >> 9; r &= 511; N = 1024; k0 = (r >> 5) * 64; n0 = (r & 31) * 32; src = a.in[16] + (size_t)j * 1024 * 1024; dst = W + W_PW2 + (size_t)j * 1024 * 1024; drow = n0; }
            else if (r < 6144) { r -= 3072; const int j = r / 1536; r %= 1536; N = 3072; k0 = (r / 96) * 64; n0 = (r % 96) * 32; src = a.in[18] + (size_t)j * 1024 * 3072; dst = W + W_QKV + (size_t)j * 3072 * 1024; drow = n0;
                cbl = CB + (size_t)(((2 * j + 1) * 3 + 1) * 2) * 5632; shl = MODS + ((2 * j + 1) * 2) * 9216 + 3 * 1024; }
            else { r -= 6144; const int j = r >> 9; r &= 511; N = 1024; k0 = (r >> 5) * 64; n0 = (r & 31) * 32; src = a.in[21] + (size_t)j * 1024 * 1024; dst = W + W_O + (size_t)j * 1024 * 1024; drow = n0; }
        }
        return ConvDesc{src, dst, cbl, shl, K, N, k0, n0, drow};
    }
__device__ __forceinline__ void convert_layer_range(const Args& a, LAS unsigned char* lds, const float* MODS, float* CB, bf16_t* W, int L, int lo, int hi, int rank, int nwaves, int w, int lane) {
    LAS float* scr = (LAS float*)(lds + w * 16384);
    const bool nts = L > 0;
    int idx = lo + rank; if (idx >= hi) return;
    ConvDesc dA = convert_decode(a, layer_item_to_global(L, idx), MODS, CB, W), dB = dA, dC = dA; f32x4 vA[8], vB[8], vC[8]; f32x2 sA, sB, sC;
    convert_load(dA, lane, vA, sA);
    bool hB = idx + nwaves < hi; if (hB) { dB = convert_decode(a, layer_item_to_global(L, idx + nwaves), MODS, CB, W); convert_load(dB, lane, vB, sB); }
    for (;;) {
        bool hC = hB && (idx + 2 * nwaves < hi); if (hC) { dC = convert_decode(a, layer_item_to_global(L, idx + 2 * nwaves), MODS, CB, W); convert_load(dC, lane, vC, sC); }
        convert_finish(dA, vA, sA, scr, lane, nts); if (!hB) break; idx += nwaves;
        bool hA = hC && (idx + 2 * nwaves < hi); if (hA) { dA = convert_decode(a, layer_item_to_global(L, idx + 2 * nwaves), MODS, CB, W); convert_load(dA, lane, vA, sA); }
        convert_finish(dB, vB, sB, scr, lane, nts); if (!hC) break; idx += nwaves;
        hB = hA && (idx + 2 * nwaves < hi); if (hB) { dB = convert_decode(a, layer_item_to_global(L, idx + 2 * nwaves), MODS, CB, W); convert_load(dB, lane, vB, sB); }
        convert_finish(dC, vC, sC, scr, lane, nts); if (!hA) break; idx += nwaves;
    }
}
__device__ __forceinline__ void prologue_b(const Args& a, LAS unsigned char* lds, const float* MODS, float* CB, float* GT, float* GATE, float* SSQ, bf16_t* W, bf16_t* XB) {
    const int tid = opaque_tid(), G = gridDim.x, b = blockIdx.x, w = __builtin_amdgcn_readfirstlane(tid >> 6), lane = tid & 63;
    for (int i = b * 512 + tid; i < 4 * 3 * 2 * 1024; i += G * 512) {
        const int d = i & 1023, r = i >> 10, st = r & 1, ls = r >> 1, s = ls % 3, layer = ls / 3;
        const float* m = MODS + (layer * 2 + st) * 9216;
        GT[i] = a.in[6][(layer * 3 + s) * 1024 + d] * (1.f + m[(3 * s + 1) * 1024 + d]);
        GATE[i] = (s == 1 ? 1.f : 0.5f) * m[(3 * s + 2) * 1024 + d];
    }
    const int gw = b * 8 + w, NGW = G * 8;
    for (int L = 0; L < 4; ++L) convert_layer_range(a, lds, MODS, CB, W, L, 0, layer_items(L), gw, NGW, w, lane);
    for (int r0 = gw; r0 < NR; r0 += 2 * NGW) {
        f32x4 v[2][4];
#pragma unroll
        for (int q = 0; q < 2; ++q) { const int r = r0 + q * NGW; if (r < NR) { const float* xr = (r >= T_LAT) ? a.in[2] + (size_t)(r - T_LAT) * 1024 : a.in[0] + (size_t)r * 1024;
#pragma unroll
            for (int j = 0; j < 4; ++j) v[q][j] = *(const f32x4*)(xr + 4 * lane + 256 * j); } }
#pragma unroll
        for (int q = 0; q < 2; ++q) { const int r = r0 + q * NGW; if (r < NR) { const int st = r >= T_LAT; const float* m = MODS + st * 9216 + 1024; float s = 0.f;
#pragma unroll
            for (int j = 0; j < 4; ++j) { const int c = 4 * lane + 256 * j; const f32x4 x4 = v[q][j]; s += (x4[0] * x4[0] + x4[1] * x4[1]) + (x4[2] * x4[2] + x4[3] * x4[3]);
                const f32x4 g = *(const f32x4*)(a.in[6] + c) * (*(const f32x4*)(m + c) + 1.f); const f32x4 z = x4 * g;
                u32x2 o; o.x = cvt_pk_bf16(z[0], z[1]); o.y = cvt_pk_bf16(z[2], z[3]); *(u32x2*)(XB + (size_t)r * 1024 + c) = o; }
            s = wave_sum(s); if (lane == 0) SSQ[r] = s; } }
    }
}

template <int NB, int NCH, class Epi>
__device__ __forceinline__ void ctx_gemm(LAS unsigned char* lds, const bf16_t* A, const bf16_t* Bt, int K, int ncb, const Epi& E, int cb0 = 0) {
    const int tid = opaque_tid(), w = __builtin_amdgcn_readfirstlane(tid >> 6), lane = tid & 63, r = lane & 31, hh = lane >> 5;
    constexpr int KW = NCH * 32, BATCH = (NB == 1) ? NCH : 6;
    LAS float* red = (LAS float*)lds;
    for (int u = blockIdx.x; u < 8 * ncb; u += gridDim.x) {
        const int rt = u & 7, cb = cb0 + (u >> 3);
        const bf16_t* ap = A + (size_t)(32 * rt + r) * K + w * KW + 16 * hh;
        const bf16_t* bp[NB];
#pragma unroll
        for (int nb = 0; nb < NB; ++nb) bp[nb] = Bt + (size_t)E.brow(32 * cb + r, nb) * K + w * KW + 16 * hh;
        typename Epi::Pre pre[2];
#pragma unroll
        for (int jj = 0; jj < 2; ++jj) { const int reg = (tid >> 6) + 8 * jj; pre[jj] = E.prefetch(32 * rt + (reg & 3) + 8 * (reg >> 2) + 4 * hh, 32 * cb + r); }
        f32x16 acc[NB];
#pragma unroll
        for (int nb = 0; nb < NB; ++nb)
#pragma unroll
            for (int e = 0; e < 16; ++e) acc[nb][e] = 0.f;
#pragma unroll
        for (int c0 = 0; c0 < NCH; c0 += BATCH) {
            bf16x8 af[BATCH][2], bf[NB][BATCH][2];
#pragma unroll
            for (int c = 0; c < BATCH; ++c) if (c0 + c < NCH) {
                af[c][0] = *(const bf16x8*)(ap + (c0 + c) * 32); af[c][1] = *(const bf16x8*)(ap + (c0 + c) * 32 + 8);
#pragma unroll
                for (int nb = 0; nb < NB; ++nb) { bf[nb][c][0] = *(const bf16x8*)(bp[nb] + (c0 + c) * 32); bf[nb][c][1] = *(const bf16x8*)(bp[nb] + (c0 + c) * 32 + 8); }
            }
#pragma unroll
            for (int c = 0; c < BATCH; ++c) if (c0 + c < NCH) {
#pragma unroll
                for (int nb = 0; nb < NB; ++nb) { acc[nb] = __builtin_amdgcn_mfma_f32_32x32x16_bf16(af[c][0], bf[nb][c][0], acc[nb], 0, 0, 0); acc[nb] = __builtin_amdgcn_mfma_f32_32x32x16_bf16(af[c][1], bf[nb][c][1], acc[nb], 0, 0, 0); }
            }
        }
#pragma unroll
        for (int nb = 0; nb < NB; ++nb)
#pragma unroll
            for (int e = 0; e < 16; ++e) red[((w * NB + nb) * 16 + e) * 64 + lane] = acc[nb][e];
        __syncthreads();
#pragma unroll
        for (int jj = 0; jj < 2; ++jj) {
            const int reg = (tid >> 6) + 8 * jj; float v[NB];
#pragma unroll
            for (int nb = 0; nb < NB; ++nb) { float s = 0.f;
#pragma unroll
                for (int w2 = 0; w2 < 8; ++w2) s += red[((w2 * NB + nb) * 16 + reg) * 64 + lane];
                v[nb] = s; }
            const int row = (reg & 3) + 8 * (reg >> 2) + 4 * hh, col = r;
            E.apply(pre[jj], 32 * rt + row, 32 * cb + col, v[0], NB > 1 ? v[NB - 1] : 0.f);
        }
        __syncthreads();
    }
}
struct CtxGlu {
    bf16_t* O; const float* ssq; const float* cb;
    struct Pre { float ss, c0, c1; };
    __device__ __forceinline__ int brow(int c, int nb) const { return 256 * (c >> 7) + (c & 127) + 128 * nb; }
    __device__ __forceinline__ Pre prefetch(int row, int col) const { const int c = 256 * (col >> 7) + (col & 127); return Pre{ssq[T_LAT + row], cb[c], cb[c + 128]}; }
    __device__ __forceinline__ void apply(const Pre& p, int row, int col, float v0, float v1) const {
        const float rs = __builtin_amdgcn_rsqf(p.ss * (1.0f / 1024.0f) + pg8::RMS_EPS_F);
        const float a0 = v0 * rs + p.c0, g0 = v1 * rs + p.c1;
        O[(size_t)(T_LAT + row) * 1024 + col] = (bf16_t)(cvt_pk_bf16(a0 * sigmoid_f(g0), 0.f) & 0xffffu);
    }
};
struct CtxQkv {
    bf16_t* O; const float* ssq; const float* cb; float qscale;
    struct Pre { float ss, c0; };
    __device__ __forceinline__ int brow(int c, int) const { return c; }
    __device__ __forceinline__ Pre prefetch(int row, int col) const { return Pre{ssq[T_LAT + row], cb[col]}; }
    __device__ __forceinline__ void apply(const Pre& p, int row, int col, float v0, float) const {
        const float rs = __builtin_amdgcn_rsqf(p.ss * (1.0f / 1024.0f) + pg8::RMS_EPS_F);
        const float v = (v0 * rs + p.c0) * (col < 1024 ? qscale : 1.f);
        O[(size_t)(T_LAT + row) * 3072 + col] = (bf16_t)(cvt_pk_bf16(v, 0.f) & 0xffffu);
    }
};
struct CtxResid {
    const float* xold; float* xnew; bf16_t* xb; float* ssq_out; const float* gate; const float* bias; const float* gn; bool dry;
    struct Pre { float x, g, b, n; };
    __device__ __forceinline__ int brow(int c, int) const { return c; }
    __device__ __forceinline__ Pre prefetch(int row, int col) const { return Pre{xold[(size_t)row * 1024 + col], gate[col], bias ? bias[col] : 0.f, gn[col]}; }
    __device__ __forceinline__ void apply(const Pre& p, int row, int col, float v0, float) const {
        const float y = p.x + p.g * (v0 + p.b);
        if (!dry) { xnew[(size_t)row * 1024 + col] = y; xb[(size_t)(T_LAT + row) * 1024 + col] = (bf16_t)(cvt_pk_bf16(y * p.n, 0.f) & 0xffffu); }
        float s = y * y;
        s += __shfl_xor(s, 1); s += __shfl_xor(s, 2); s += __shfl_xor(s, 4); s += __shfl_xor(s, 8); s += __shfl_xor(s, 16);
        if ((col & 31) == 0 && !dry) atomicAdd(ssq_out + T_LAT + row, s);
    }
};

__device__ __forceinline__ void conv_ln_token(const LAS float* cvrow, const float* lng, const float* lnb, bf16_t* vrow, int lane) {
    f32x4 v[4]; float s = 0.f;
#pragma unroll
    for (int jj = 0; jj < 4; ++jj) { v[jj] = *(const LAS f32x4*)(cvrow + 4 * lane + 256 * jj); s += (v[jj][0] + v[jj][1]) + (v[jj][2] + v[jj][3]); }
    const float mean = wave_sum(s) * (1.0f / 1024.0f); float s2 = 0.f;
#pragma unroll
    for (int jj = 0; jj < 4; ++jj) { v[jj] = v[jj] - mean; s2 += (v[jj][0] * v[jj][0] + v[jj][1] * v[jj][1]) + (v[jj][2] * v[jj][2] + v[jj][3] * v[jj][3]); }
    const float rstd = __builtin_amdgcn_rsqf(wave_sum(s2) * (1.0f / 1024.0f) + 1e-5f);
#pragma unroll
    for (int jj = 0; jj < 4; ++jj) { const int c = 4 * lane + 256 * jj; const f32x4 y = v[jj] * rstd * *(const f32x4*)(lng + c) + *(const f32x4*)(lnb + c);
        u32x2 o; o.x = cvt_pk_bf16(y[0] * sigmoid_f(y[0]), y[1] * sigmoid_f(y[1])); o.y = cvt_pk_bf16(y[2] * sigmoid_f(y[2]), y[3] * sigmoid_f(y[3]));
        *(u32x2*)(vrow + c) = o; }
}
__device__ __forceinline__ void conv_mid(const Args& a, LAS unsigned char* lds, int j, const bf16_t* U, bf16_t* V) {
    const int tid = opaque_tid(), w = tid >> 6, lane = tid & 63, ch = 2 * tid;
    const float* wdw = a.in[12] + (size_t)j * 31 * 1024; const float* bdw = a.in[13] + j * 1024; const float* lng = a.in[14] + j * 1024; const float* lnb = a.in[15] + j * 1024;
    f32x2 wv[31];
#pragma unroll
    for (int i = 0; i < 31; ++i) wv[i] = *(const f32x2*)(wdw + i * 1024 + ch);
    const f32x2 bd = *(const f32x2*)(bdw + ch);
    LAS float* cv = (LAS float*)lds;
    for (int ct = blockIdx.x; ct < T_CTX; ct += gridDim.x) {
        unsigned raw[31];
#pragma unroll
        for (int r = 0; r < 31; ++r) { const int t = min(max(ct - 15 + r, 0), T_CTX - 1); raw[r] = *(const unsigned*)(U + (size_t)(T_LAT + t) * 1024 + ch); }
        f32x2 acc = bd;
#pragma unroll
        for (int r = 0; r < 31; ++r) { const int t = ct - 15 + r; const bool ok = (t >= 0) && (t < T_CTX); f32x2 u; u.x = ok ? bf_lo(raw[r]) : 0.f; u.y = ok ? bf_hi(raw[r]) : 0.f; acc += u * wv[r]; }
        *(LAS f32x2*)(cv + ch) = acc;
        __syncthreads();
        if (w == 0) conv_ln_token(cv, lng, lnb, V + (size_t)(T_LAT + ct) * 1024, lane);
        __syncthreads();
    }
    constexpr int TPI = 8, WIN = 30 + TPI, NIT = 64 / TPI;
    for (int c64 = blockIdx.x; c64 < T_LAT / 64; c64 += gridDim.x) {
        const int t0 = 64 * c64; const bf16_t* up = U + ch;
        f32x2 u[WIN];
        { unsigned raw[WIN];
#pragma unroll
          for (int i = 0; i < WIN; ++i) { const int t = min(max(t0 - 15 + i, 0), T_LAT - 1); raw[i] = *(const unsigned*)(up + (size_t)t * 1024); }
#pragma unroll
          for (int i = 0; i < WIN; ++i) { const int t = t0 - 15 + i; const bool ok = (t >= 0) && (t < T_LAT); u[i].x = ok ? bf_lo(raw[i]) : 0.f; u[i].y = ok ? bf_hi(raw[i]) : 0.f; } }
        unsigned nrA[TPI];
#pragma unroll
        for (int k = 0; k < TPI; ++k) { const int t = min(t0 + WIN - 15 + k, T_LAT - 1); nrA[k] = *(const unsigned*)(up + (size_t)t * 1024); }
#pragma unroll 1
        for (int it = 0; it < NIT; ++it) {
            unsigned nrB[TPI];
#pragma unroll
            for (int k = 0; k < TPI; ++k) { const int t = min(t0 + TPI * it + WIN - 15 + TPI + k, T_LAT - 1); nrB[k] = *(const unsigned*)(up + (size_t)t * 1024); }
            f32x2 o[TPI];
#pragma unroll
            for (int k = 0; k < TPI; ++k) o[k] = bd;
#pragma unroll
            for (int jj = 0; jj < 31; ++jj)
#pragma unroll
                for (int k = 0; k < TPI; ++k) o[k] += u[k + jj] * wv[jj];
#pragma unroll
            for (int k = 0; k < TPI; ++k) *(LAS f32x2*)(cv + ((TPI * it + k) & 31) * 1024 + ch) = o[k];
#pragma unroll
            for (int i = 0; i < 30; ++i) u[i] = u[i + TPI];
#pragma unroll
            for (int k = 0; k < TPI; ++k) { const bool ok = (t0 + TPI * it + WIN - 15 + k) < T_LAT; u[30 + k].x = ok ? bf_lo(nrA[k]) : 0.f; u[30 + k].y = ok ? bf_hi(nrA[k]) : 0.f; nrA[k] = nrB[k]; }
            if ((it & (32 / TPI - 1)) == 32 / TPI - 1) {
                __syncthreads();
#pragma unroll 1
                for (int q = 0; q < 4; ++q) { const int tt = 4 * w + q; conv_ln_token(cv + tt * 1024, lng, lnb, V + (size_t)(t0 + 32 * (it / (32 / TPI)) + tt) * 1024, lane); }
                __syncthreads();
            }
        }
    }
}

__device__ __forceinline__ void attn_softmax_pv(f32x16& S, const u32x4 (&vc)[4], int t, const LAS float* tb, LAS unsigned char* vbuf, unsigned vst_off, unsigned vrd_off,
                                                int r0a, int r0q, int qrow, int bidx0, unsigned cm, f32x16& o0, f32x16& o1, float& m, float& l) {
    if (t >= 8) { const int jr = r0a + t - 8; const unsigned vm = ((jr >= r0q) & (jr < r0q + 8)) ? cm : 0u; const LAS float* tr = tb + (jr - qrow + 7) * 64 + bidx0;
        float bz[16];
#pragma unroll
        for (int reg = 0; reg < 16; ++reg) { bz[reg] = tr[(reg & 3) + 8 * (reg >> 2)]; }
#pragma unroll
        for (int reg = 0; reg < 16; ++reg) { asm volatile("" : "+v"(bz[reg])); }
#pragma unroll
        for (int reg = 0; reg < 16; ++reg) { const float sb = S[reg] + bz[reg];
            const unsigned keep = (unsigned)__builtin_amdgcn_sbfe((int)vm, reg, 1);
            S[reg] = __uint_as_float((__float_as_uint(sb) & keep) | (0xf149f2cau & ~keep)); } }
    float mx = S[0];
#pragma unroll
    for (int e = 1; e < 16; ++e) mx = fmaxf(mx, S[e]);
    mx = fmaxf(mx, __shfl_xor(mx, 32));
    if (__builtin_amdgcn_ballot_w64(mx > m + 8.0f) != 0ull) {
        const float mnew = fmaxf(m, mx), alpha = __builtin_amdgcn_exp2f(m - mnew); m = mnew; l *= alpha;
#pragma unroll
        for (int e = 0; e < 16; ++e) { o0[e] *= alpha; o1[e] *= alpha; }
    }
    float ps = 0.f;
#pragma unroll
    for (int e = 0; e < 16; ++e) { S[e] = __builtin_amdgcn_exp2f(S[e] - m); ps += S[e]; }
    l += ps;
    bf16x8 pf[2];
#pragma unroll
    for (int s2 = 0; s2 < 2; ++s2) { u32x4 pw; pw.x = cvt_pk_bf16(S[8 * s2 + 0], S[8 * s2 + 1]); pw.y = cvt_pk_bf16(S[8 * s2 + 2], S[8 * s2 + 3]); pw.z = cvt_pk_bf16(S[8 * s2 + 4], S[8 * s2 + 5]); pw.w = cvt_pk_bf16(S[8 * s2 + 6], S[8 * s2 + 7]);
        pf[s2] = __builtin_bit_cast(bf16x8, pw); }
#pragma unroll
    for (int i = 0; i < 4; ++i) *(LAS u32x4*)(vbuf + vst_off + i * 512) = vc[i];
#pragma unroll
    for (int s2 = 0; s2 < 2; ++s2) {
#pragma unroll
        for (int dt = 0; dt < 2; ++dt) {
            const v4i16_t lo = __builtin_amdgcn_ds_read_tr16_b64_v4i16((LAS v4i16_t*)(vbuf + vrd_off + dt * 2048 + s2 * 1024));
            const v4i16_t hi = __builtin_amdgcn_ds_read_tr16_b64_v4i16((LAS v4i16_t*)(vbuf + vrd_off + dt * 2048 + s2 * 1024 + 512));
            bf16x8 vf; vf[0] = lo[0]; vf[1] = lo[1]; vf[2] = lo[2]; vf[3] = lo[3]; vf[4] = hi[0]; vf[5] = hi[1]; vf[6] = hi[2]; vf[7] = hi[3];
            if (dt == 0) o0 = __builtin_amdgcn_mfma_f32_32x32x16_bf16(vf, pf[s2], o0, 0, 0, 0); else o1 = __builtin_amdgcn_mfma_f32_32x32x16_bf16(vf, pf[s2], o1, 0, 0, 0);
        }
    }
}
__device__ __forceinline__ void attn_unit(const bf16_t* __restrict__ QKV, bf16_t* __restrict__ O, const LAS float* tb, LAS unsigned char* vbuf, int h, bool ctxq, int rp, int n, int lane) {
    const int ql = lane & 31, hh = lane >> 5;
    int qrow = 0, qcol = 0, qtok, cs = 0, r0a = 0, nlat = 0, r0q = 0, ws = 0;
    if (ctxq) { qtok = T_LAT + 32 * rp + ql; }
    else { qrow = 2 * rp + (ql >> 4); qcol = 16 * n + (ql & 15); qtok = qrow * 64 + qcol; cs = min(max(16 * n - 8, 0), 32); ws = min(max(qcol - 8, 0), 48);
        r0a = min(max(2 * rp - 4, 0), 248); const int r0b = min(max(2 * rp - 3, 0), 248); nlat = r0b - r0a + 8; r0q = (ql >> 4) ? r0b : r0a; }
    const int ntiles = 8 + nlat;
    bf16x8 qf[4];
    { const bf16_t* qp = QKV + (size_t)qtok * 3072 + h * 64 + 8 * hh;
#pragma unroll
      for (int s = 0; s < 4; ++s) qf[s] = *(const bf16x8*)(qp + 16 * s); }
    unsigned cm = 0;
#pragma unroll
    for (int reg = 0; reg < 16; ++reg) { const int kreg = (reg & 3) + 8 * (reg >> 2); cm |= ((unsigned)(cs + 4 * hh + kreg - ws) < 16u ? 1u : 0u) << reg; }
    const int bidx0 = cs + 4 * hh - qcol + 32;
    const int skey = lane >> 3, sch = lane & 7;
    const unsigned vst_off = (unsigned)((sch >> 2) * 2048 + (sch & 3) * 16 + skey * 64);
    const unsigned vrd_off = (unsigned)(((lane >> 4) & 1) * 32 + (lane & 3) * 8 + (4 * hh + ((lane & 15) >> 2)) * 64);
    const bf16_t* kbase = QKV + 1024 + h * 64 + 8 * hh + (size_t)ql * 3072;
    const bf16_t* vbase = QKV + 2048 + h * 64 + 8 * sch + (size_t)skey * 3072;
    f32x16 o0, o1;
#pragma unroll
    for (int e = 0; e < 16; ++e) { o0[e] = 0.f; o1[e] = 0.f; }
    float m = -1e30f, l = 0.f;
    bf16x8 kA[4], kB[4]; u32x4 vA[4], vB[4]; f32x16 SA, SB;
#define ATT_TOKBASE(t) ((t) < 8 ? T_LAT + 32 * (t) : (r0a + (t) - 8) * 64 + cs)
#define ATT_LOADK(dst, tile) do { const size_t tbs_ = (size_t)ATT_TOKBASE(tile) * 3072; _Pragma("unroll") for (int s = 0; s < 4; ++s) dst[s] = *(const bf16x8*)(kbase + tbs_ + 16 * s); } while (0)
#define ATT_LOADV(dst, tile) do { const size_t tbs_ = (size_t)ATT_TOKBASE(tile) * 3072; _Pragma("unroll") for (int s = 0; s < 4; ++s) dst[s] = *(const u32x4*)(vbase + tbs_ + (size_t)(8 * s) * 3072); } while (0)
#define ATT_QK(S, K) do { _Pragma("unroll") for (int e = 0; e < 16; ++e) S[e] = 0.f; _Pragma("unroll") for (int s = 0; s < 4; ++s) S = __builtin_amdgcn_mfma_f32_32x32x16_bf16(K[s], qf[s], S, 0, 0, 0); } while (0)
#define ATT_STEP(t, Scur, Snext, Kfree, Knext, Vcur, Vnext) do { \
        { const int t2_ = min((t) + 2, ntiles - 1); ATT_LOADK(Kfree, t2_); } { const int t1_ = min((t) + 1, ntiles - 1); ATT_LOADV(Vnext, t1_); } \
        ATT_QK(Snext, Knext); \
        attn_softmax_pv(Scur, Vcur, (t), tb, vbuf, vst_off, vrd_off, r0a, r0q, qrow, bidx0, cm, o0, o1, m, l); } while (0)
    ATT_LOADK(kA, 0); ATT_LOADV(vA, 0); ATT_LOADK(kB, 1);
    ATT_QK(SA, kA);
    int t = 0;
#pragma unroll 1
    for (; t + 1 < ntiles; t += 2) { ATT_STEP(t, SA, SB, kA, kB, vA, vB); ATT_STEP(t + 1, SB, SA, kB, kA, vB, vA); }
    if (t < ntiles) ATT_STEP(t, SA, SB, kA, kB, vA, vB);
#undef ATT_STEP
#undef ATT_QK
#undef ATT_LOADV
#undef ATT_LOADK
#undef ATT_TOKBASE
    l += __shfl_xor(l, 32);
    const float inv = 1.0f / l;
    bf16_t* op = O + (size_t)qtok * 1024 + h * 64 + 4 * hh;
#pragma unroll
    for (int rg = 0; rg < 4; ++rg) {
        u32x2 a0; a0.x = cvt_pk_bf16(o0[4 * rg] * inv, o0[4 * rg + 1] * inv); a0.y = cvt_pk_bf16(o0[4 * rg + 2] * inv, o0[4 * rg + 3] * inv); *(u32x2*)(op + 8 * rg) = a0;
        u32x2 a1; a1.x = cvt_pk_bf16(o1[4 * rg] * inv, o1[4 * rg + 1] * inv); a1.y = cvt_pk_bf16(o1[4 * rg + 2] * inv, o1[4 * rg + 3] * inv); *(u32x2*)(op + 32 + 8 * rg) = a1;
    }
}
__device__ __forceinline__ void attn_mid(const Args& a, LAS unsigned char* lds, int j, bool ctx_q, const bf16_t* QKV, bf16_t* O) {
    const int tid = opaque_tid(), w = __builtin_amdgcn_readfirstlane(tid >> 6), lane = tid & 63;
    LAS float* tb = (LAS float*)lds;
    LAS unsigned char* vbuf = lds + 4096 + w * 4096;
    for (int wu = blockIdx.x; wu < 256; wu += gridDim.x) {
        const int h = wu & 15, g = wu >> 4;
        __syncthreads();
        for (int e = tid; e < 1024; e += 512) { const int dr = e >> 6, dc = (e & 63) - 32; float v = 0.f;
            if (dr < 15 && dc >= -15 && dc <= 15) v = a.in[20][((size_t)(j * NHEAD + h) * 15 + dr) * 31 + dc + 15] * LOG2E;
            tb[e] = v; }
        __syncthreads();
        const int nun = (ctx_q && wu < 128 && w == 0) ? 5 : 4;
        for (int i = 0; i < nun; ++i) { const bool cq = (i == 4); const int tl = g * 32 + w * 4 + i; attn_unit(QKV, O, tb, vbuf, h, cq, cq ? (wu >> 4) : (tl >> 2), tl & 3, lane); }
    }
}
constexpr int N_PHASES = 31;
__device__ __forceinline__ const Args* args_ptr() {
    auto p = __builtin_amdgcn_kernarg_segment_ptr(); asm volatile("" : "+s"(p)); return (const Args*)p;
}
#define WS_PTRS(a) unsigned char* ws = (a).ws; float* MODS = (float*)(ws + WS_MODS); float* CB = (float*)(ws + WS_CB); float* GT = (float*)(ws + WS_GT); float* GATE = (float*)(ws + WS_GATE); \
    float* SSQ = (float*)(ws + WS_SSQ); float* XC = (float*)(ws + WS_XC); bf16_t* W = (bf16_t*)(ws + WS_W); bf16_t* XB = (bf16_t*)(ws + WS_XB); bf16_t* H = (bf16_t*)(ws + WS_H); bf16_t* OB = (bf16_t*)(ws + WS_H); \
    bf16_t* QKV = (bf16_t*)(ws + WS_QKV); bf16_t* UB = QKV; bf16_t* VB = QKV + (size_t)NR * 1024; float* X = (a).out; \
    (void)MODS; (void)CB; (void)GT; (void)GATE; (void)SSQ; (void)XC; (void)W; (void)XB; (void)H; (void)OB; (void)QKV; (void)UB; (void)VB; (void)X
__global__ void __launch_bounds__(512, 2) fwd_megakernel(Args a_) {
    LAS unsigned char* lds = (LAS unsigned char*)lds_raw;
    if ((threadIdx.x & 63) == 0) ((LAS unsigned*)(lds + LDS_TIDTAB))[hw_wave_key()] = threadIdx.x >> 6;
    const int lo = a_.ph_lo, hi = a_.ph_hi;
#define IN(k) (lo <= (k) && (k) < hi)
#if MK_SPLIT
#define SEAM(k) do { } while (0)
#else
#ifdef PROBE_BAR2
#define SEAM(k) do { if (IN(k) && IN((k) + 1)) { xcd_barrier(bar); xcd_barrier(bar); } } while (0)
#else
#define SEAM(k) do { if (IN(k) && IN((k) + 1)) xcd_barrier(bar); } while (0)
#endif
#endif
    unsigned* barw = (unsigned*)(a_.ws + WS_BAR);
    volatile LAS unsigned* bst = (volatile LAS unsigned*)(lds + 131072 + 4096);
    if (threadIdx.x < 2) bst[threadIdx.x] = 0u;
    __syncthreads();
    #ifndef DIS_PA
    if (IN(0)) { const Args& a = *args_ptr(); WS_PTRS(a); prologue_a(a, lds, MODS, CB, SSQ); }
#endif
#if MK_SPLIT
    XcdBarrier bar; bar.bar = barw; bar.x = 0; bar.st = bst;
#else
    if (lo < 0) cg::this_grid().sync();
    XcdBarrier bar = xcd_barrier_post(barw, bst);
#endif
    SEAM(0);
#ifndef DIS_PB
    if (IN(1)) { const Args& a = *args_ptr(); WS_PTRS(a); prologue_b(a, lds, MODS, CB, GT, GATE, SSQ, W, XB); }
#endif
    SEAM(1);
#ifdef DUPMASK
    bool dup_second = false;
#endif
    for (int st = 0; st < 28; ++st) {
        if (IN(2 + st)) {
            const Args& a = *args_ptr(); WS_PTRS(a);
            int st_o = st; asm volatile("" : "+s"(st_o));
            const int layer = st_o / 7, k = st_o % 7, j = layer >> 1; const bool conv = (layer & 1) == 0, last = layer == 3;
#ifdef DUPMASK
            const bool dup_this = (((DUPMASK) >> k) & 1) && (((DUPLAYERS) >> layer) & 1);
            const bool dry = dup_this && !dup_second;
#else
            const bool dry = false;
#endif
            if (k != 3) {
                pg8::Gemm g; pg8::EpiAny E{}; E.dry = dry;
                const float* gate_l = nullptr; const float* gn_l = nullptr; float* ssq_out = nullptr; const float* bias = nullptr; bool first = false;
                if (k == 0 || k == 5) { const int s = (k == 0) ? 0 : 1, slot = 2 * s;
                    g = pg8::Gemm{XB, W + W_GU + (size_t)(layer * 2 + s) * 5632 * 1024, (k == 5 && last) ? T_LAT : NR, 5632, 1024};
                    E.kind = 0; E.p0 = (pg8::EpiAny::gptr)(H); E.i0 = FF; E.p1 = (pg8::EpiAny::gptr)(SSQ + (size_t)(3 * layer + slot) * NR); E.p2 = (pg8::EpiAny::gptr)(CB + (size_t)((layer * 3 + slot) * 2) * 5632); E.p3 = (pg8::EpiAny::gptr)(CB + (size_t)((layer * 3 + slot) * 2 + 1) * 5632); }
                else if (k == 2 && conv) { g = pg8::Gemm{XB, W + W_PW1 + (size_t)j * 2048 * 1024, T_LAT, 2048, 1024};
                    E.kind = 1; E.p0 = (pg8::EpiAny::gptr)(UB); E.i0 = 1024; E.p1 = (pg8::EpiAny::gptr)(SSQ + (size_t)(3 * layer + 1) * NR); E.p2 = (pg8::EpiAny::gptr)(CB + (size_t)((layer * 3 + 1) * 2) * 5632); E.p3 = (pg8::EpiAny::gptr)(CB + (size_t)((layer * 3 + 1) * 2 + 1) * 5632); }
                else if (k == 2) { g = pg8::Gemm{XB, W + W_QKV + (size_t)j * 3072 * 1024, T_LAT, 3072, 1024};
                    E.kind = 2; E.p0 = (pg8::EpiAny::gptr)(QKV); E.p1 = (pg8::EpiAny::gptr)(SSQ + (size_t)(3 * layer + 1) * NR); E.p2 = (pg8::EpiAny::gptr)(CB + (size_t)((layer * 3 + 1) * 2) * 5632); E.f0 = 0.125f * LOG2E; }
                else { const int s = (k == 1) ? 0 : (k == 4 ? 1 : 2);
                    const bf16_t* A; const bf16_t* Bt; int K;
                    if (k == 4) { K = 1024; if (conv) { A = VB; Bt = W + W_PW2 + (size_t)j * 1024 * 1024; bias = a.in[17] + j * 1024; } else { A = OB; Bt = W + W_O + (size_t)j * 1024 * 1024; bias = a.in[22] + j * 1024; } }
                    else { K = FF; A = H; Bt = W + W_D + (size_t)(layer * 2 + (k == 6 ? 1 : 0)) * 1024 * FF; }
                    const int ns = (s == 2) ? (last ? (3 * 3 + 2) : ((layer + 1) * 3)) : (layer * 3 + s + 1);
                    gate_l = GATE + (size_t)((layer * 3 + s) * 2) * 1024; gn_l = GT + (size_t)(ns * 2) * 1024;
                    ssq_out = SSQ + (size_t)(3 * layer + s + 1) * NR; first = (layer == 0 && k == 1);
                    g = pg8::Gemm{A, Bt, T_LAT, 1024, K};
                    E.kind = 3; E.p0 = (pg8::EpiAny::gptr)(first ? a.in[0] : X); E.p1 = (pg8::EpiAny::gptr)(X); E.p2 = (pg8::EpiAny::gptr)((last && k == 6) ? (bf16_t*)nullptr : XB); E.p3 = (pg8::EpiAny::gptr)(ssq_out); E.p4 = (pg8::EpiAny::gptr)(gate_l); E.p5 = (pg8::EpiAny::gptr)(bias); E.p6 = (pg8::EpiAny::gptr)(gn_l); }
                pg8::StaticOrder S; S.init(g.M, g.N, (int)gridDim.x, (int)blockIdx.x);
#ifndef DIS_G1
                pg8::gemm_phase<pg8::EpiAny, pg8::StaticOrder, true, true>(lds, g, S, E);
#endif
                if (k == 2 && conv) { __syncthreads();
                    CtxGlu CE{UB, SSQ + (size_t)(3 * layer + 1) * NR, CB + (size_t)((layer * 3 + 1) * 2 + 1) * 5632};
#ifndef DIS_C1
                    ctx_gemm<2, 4, CtxGlu>(lds, XB + (size_t)T_LAT * 1024, g.Bt, 1024, 32, CE);
#endif
                } else if (k == 2) { __syncthreads();
                    CtxQkv CE{QKV, SSQ + (size_t)(3 * layer + 1) * NR, CB + (size_t)((layer * 3 + 1) * 2 + 1) * 5632, 0.125f * LOG2E};
#ifndef DIS_C2
                    ctx_gemm<1, 4, CtxQkv>(lds, XB + (size_t)T_LAT * 1024, g.Bt, 1024, last ? 64 : 96, CE, last ? 32 : 0);
#endif
                } else if ((k == 1 || k == 4 || k == 6) && !(last && k >= 4)) { __syncthreads();
                    CtxResid CE{first ? a.in[2] : XC, XC, XB, ssq_out, gate_l + 1024, bias, gn_l + 1024, dry};
#ifndef DIS_C3
                    if (g.K == 1024) ctx_gemm<1, 4, CtxResid>(lds, g.A + (size_t)T_LAT * 1024, g.Bt, 1024, 32, CE);
                    else ctx_gemm<1, 11, CtxResid>(lds, g.A + (size_t)T_LAT * FF, g.Bt, FF, 32, CE);
#endif
                }
            } else {
#ifndef DIS_CV
                if (conv) conv_mid(a, lds, j, UB, VB);
#endif
#ifndef DIS_AT
                if (!conv) attn_mid(a, lds, j, !last, QKV, OB);
#endif
            }
        }
        SEAM(2 + st);
#ifdef DUPMASK
        { const int layer2 = st / 7, k2 = st % 7; const bool dup_this2 = (((DUPMASK) >> k2) & 1) && (((DUPLAYERS) >> layer2) & 1);
          if (dup_this2 && !dup_second) { dup_second = true; --st; } else dup_second = false; }
#endif
    }
    if (IN(30)) {
        const Args& a = *args_ptr(); WS_PTRS(a);
        const int tid = opaque_tid(), w = tid >> 6, lane = tid & 63, gw = blockIdx.x * 8 + w, NGW = gridDim.x * 8;
        const float* ssq = SSQ + (size_t)12 * NR;
        f32x4 fg[4];
#pragma unroll
        for (int jj = 0; jj < 4; ++jj) fg[jj] = *(const f32x4*)(a.in[23] + 4 * lane + 256 * jj);
        for (int r0 = gw; r0 < T_LAT; r0 += 4 * NGW) {
            f32x4 v[4][4]; float rs[4];
#pragma unroll
            for (int q = 0; q < 4; ++q) { const int r = min(r0 + q * NGW, T_LAT - 1); rs[q] = ssq[r];
#pragma unroll
                for (int jj = 0; jj < 4; ++jj) v[q][jj] = *(const f32x4*)(X + (size_t)r * 1024 + 4 * lane + 256 * jj); }
#pragma unroll
            for (int q = 0; q < 4; ++q) { const int r = r0 + q * NGW; if (r < T_LAT) { const float sc = __builtin_amdgcn_rsqf(rs[q] * (1.0f / 1024.0f) + pg8::RMS_EPS_F);
#pragma unroll
                for (int jj = 0; jj < 4; ++jj) __builtin_nontemporal_store(v[q][jj] * sc * fg[jj], (f32x4*)(X + (size_t)r * 1024 + 4 * lane + 256 * jj)); } }
        }
    }
#undef IN
#undef SEAM
}

extern "C" void kernel_launch(void* const* d_in, const int* in_sizes, int n_in, void* d_out, int out_size, void* d_ws, size_t ws_size, hipStream_t stream) {
    static int grid = 0;
    if (grid == 0) {
        if (n_in != 24 || out_size != T_LAT * D || ws_size < WS_END) { fprintf(stderr, "kernel_launch: unexpected shapes (n_in %d out %d ws %zu)\n", n_in, out_size, ws_size); grid = -1; return; }
        int dev = 0, cus = 0, per_cu = 0;
        hipGetDevice(&dev); hipDeviceGetAttribute(&cus, hipDeviceAttributeMultiprocessorCount, dev);
        if (hipFuncSetAttribute((const void*)fwd_megakernel, hipFuncAttributeMaxDynamicSharedMemorySize, LDS_BYTES) != hipSuccess) { fprintf(stderr, "kernel_launch: hipFuncSetAttribute failed\n"); grid = -1; return; }
        if (hipOccupancyMaxActiveBlocksPerMultiprocessor(&per_cu, (const void*)fwd_megakernel, 512, LDS_BYTES) != hipSuccess || per_cu < 1) { fprintf(stderr, "kernel_launch: occupancy query gave %d\n", per_cu); per_cu = 1; }
        (void)hipGetLastError();
        grid = cus * (per_cu > 1 ? 1 : per_cu);
        if (grid <= 0) grid = 256;
    }
    if (grid < 0) return;
    if (hipMemsetAsync((char*)d_ws + WS_BAR, 0, XCD_BAR_WORDS * 4, stream) != hipSuccess) { fprintf(stderr, "kernel_launch: memset of the barrier words failed\n"); return; }
    Args a{};
    for (int i = 0; i < 24; ++i) a.in[i] = (const float*)d_in[i];
    a.out = (float*)d_out; a.ws = (unsigned char*)d_ws;
#if MK_SPLIT
    for (int p = 0; p < N_PHASES; ++p) { a.ph_lo = p; a.ph_hi = p + 1; hipLaunchKernelGGL(fwd_megakernel, dim3(grid), dim3(512), LDS_BYTES, stream, a); }
#else
    a.ph_lo = 0; a.ph_hi = N_PHASES;
    void* args[] = {&a};
    hipError_t e = hipLaunchCooperativeKernel((const void*)fwd_megakernel, dim3(grid), dim3(512), args, LDS_BYTES, stream);
    if (e != hipSuccess) fprintf(stderr, "kernel_launch: cooperative launch failed: %s (grid %d)\n", hipGetErrorString(e), grid);
#endif
}
```
